# Optimizing an MI355X kernel written in HIP

```python
import math
import jax, jax.numpy as jnp
from jax import lax
import numpy as np

D_MODEL = 1024
BATCH = 2
SEQ = 8192
DEPTH = 2

N_MIXERS = 2
N_ATTN_LAYERS = (DEPTH + 1) // 2
N_POOL_LAYERS = DEPTH // 2

HEAD_DIM = 64
N_Q_HEADS = D_MODEL // HEAD_DIM
N_KV_HEADS = 4
GROUP = N_Q_HEADS // N_KV_HEADS
QKV_DIM = (N_Q_HEADS + 2 * N_KV_HEADS) * HEAD_DIM
WINDOW = 128
BLOCK = 128
ROPE_DIM = HEAD_DIM // 4
ROPE_THETA = 500000.0

POOL_WINDOWS = (2, 4, 8, 16)
N_POOL_GROUPS = len(POOL_WINDOWS)
POOL_GROUP_DIM = D_MODEL // N_POOL_GROUPS

D_FF = 2816
CONV_WIDTH = 3

NORM_EPS = 1e-6
NEG_INF = -1e30

kernel_name = "hybrid_swa_sink_pool_convffn_adaln"


def rmsnorm(x, gain):
    xf = x.astype(jnp.float32)
    y = xf * lax.rsqrt(jnp.mean(xf * xf, axis=-1, keepdims=True) + NORM_EPS)
    return (y * gain.astype(jnp.float32)).astype(x.dtype)


def rope_tables(seq_len):
    half = ROPE_DIM // 2
    inv_freq = ROPE_THETA ** (-jnp.arange(0, half, dtype=jnp.float32) * 2.0 / ROPE_DIM)
    pos = jnp.arange(seq_len, dtype=jnp.float32)
    ang = pos[:, None] * inv_freq[None, :]
    return jnp.cos(ang), jnp.sin(ang)


def apply_partial_rope(x, cos, sin):
    half = ROPE_DIM // 2
    xr = x[..., :ROPE_DIM].astype(jnp.float32)
    x1, x2 = xr[..., :half], xr[..., half:]
    rot = jnp.concatenate([x1 * cos - x2 * sin, x2 * cos + x1 * sin], axis=-1)
    return jnp.concatenate([rot.astype(x.dtype), x[..., ROPE_DIM:]], axis=-1)


def swa_sink_attention(h, w_qkv, q_gain, k_gain, sinks, w_o):
    B, S, _ = h.shape
    nb = S // BLOCK
    qkv = h @ w_qkv
    q = qkv[..., :N_Q_HEADS * HEAD_DIM].reshape(B, S, N_KV_HEADS, GROUP, HEAD_DIM)
    k = qkv[..., N_Q_HEADS * HEAD_DIM:(N_Q_HEADS + N_KV_HEADS) * HEAD_DIM].reshape(B, S, N_KV_HEADS, HEAD_DIM)
    v = qkv[..., (N_Q_HEADS + N_KV_HEADS) * HEAD_DIM:].reshape(B, S, N_KV_HEADS, HEAD_DIM)
    q = rmsnorm(q, q_gain)
    k = rmsnorm(k, k_gain)
    cos, sin = rope_tables(S)
    q = apply_partial_rope(q, cos[None, :, None, None, :], sin[None, :, None, None, :])
    k = apply_partial_rope(k, cos[None, :, None, :], sin[None, :, None, :])

    qb = q.reshape(B, nb, BLOCK, N_KV_HEADS, GROUP, HEAD_DIM)
    kb = k.reshape(B, nb, BLOCK, N_KV_HEADS, HEAD_DIM)
    vb = v.reshape(B, nb, BLOCK, N_KV_HEADS, HEAD_DIM)
    k_prev = jnp.concatenate([jnp.zeros_like(kb[:, :1]), kb[:, :-1]], axis=1)
    v_prev = jnp.concatenate([jnp.zeros_like(vb[:, :1]), vb[:, :-1]], axis=1)
    k_band = jnp.concatenate([k_prev, kb], axis=2)
    v_band = jnp.concatenate([v_prev, vb], axis=2)

    scale = 1.0 / math.sqrt(HEAD_DIM)
    scores = jnp.einsum('bnqhgd,bnkhd->bnhgqk', qb, k_band).astype(jnp.float32) * scale

    qi = jnp.arange(BLOCK)[:, None]
    kj = jnp.arange(2 * BLOCK)[None, :]
    dist = BLOCK + qi - kj
    in_window = (dist >= 0) & (dist < WINDOW)
    blk = jnp.arange(nb)[:, None, None]
    key_pos = blk * BLOCK + kj[None] - BLOCK
    valid = in_window[None] & (key_pos >= 0)
    scores = jnp.where(valid[None, :, None, None], scores, NEG_INF)

    sink = sinks.astype(jnp.float32).reshape(1, 1, N_KV_HEADS, GROUP, 1, 1)
    m = jnp.maximum(jnp.max(scores, axis=-1, keepdims=True), sink)
    p = jnp.exp(scores - m)
    denom = jnp.sum(p, axis=-1, keepdims=True) + jnp.exp(sink - m)
    probs = (p / denom).astype(v.dtype)

    out = jnp.einsum('bnhgqk,bnkhd->bnqhgd', probs, v_band)
    return out.reshape(B, S, N_Q_HEADS * HEAD_DIM) @ w_o


def multiscale_pool_mixer(h, pool_w, pool_scale):
    B, S, D = h.shape
    hf = h.astype(jnp.float32)
    cs = jnp.concatenate([jnp.zeros((B, 1, D), jnp.float32), jnp.cumsum(hf, axis=1)], axis=1)
    t1 = jnp.arange(1, S + 1, dtype=jnp.float32)[None, :, None]
    diffs = []
    for g, w in enumerate(POOL_WINDOWS):
        sl = slice(g * POOL_GROUP_DIM, (g + 1) * POOL_GROUP_DIM)
        csg = cs[:, :, sl]
        win_sum = jnp.concatenate([csg[:, 1:w], csg[:, w:] - csg[:, :S + 1 - w]], axis=1)
        count = jnp.minimum(t1, float(w))
        diffs.append(win_sum / count - hf[:, :, sl])
    d = jnp.stack(diffs, axis=2)
    y = jnp.einsum('bsgc,gce->bsge', d.astype(h.dtype), pool_w).reshape(B, S, D)
    return y * pool_scale


def conv_glu_ffn(h, w_up, conv_w, conv_b, w_down):
    u = h @ w_up
    up = jnp.pad(u, ((0, 0), (CONV_WIDTH - 1, 0), (0, 0)))
    S = h.shape[1]
    u = conv_b + conv_w[0] * up[:, 0:S] + conv_w[1] * up[:, 1:S + 1] + conv_w[2] * up[:, 2:S + 2]
    gate, val = u[..., :D_FF], u[..., D_FF:]
    return (jax.nn.silu(gate) * val) @ w_down


def setup_inputs(seed: int = 0) -> dict:
    key = jax.random.key(seed)
    ks = jax.random.split(key, 20)
    D = D_MODEL
    nrm = jax.random.normal
    f32 = jnp.float32
    return {
        "x": nrm(ks[0], (BATCH, SEQ, D), f32),
        "c": nrm(ks[1], (BATCH, D), f32),
        "mod_w": nrm(ks[2], (DEPTH, D, 6 * D), f32) * (0.5 * D ** -0.5),
        "mod_b": nrm(ks[3], (DEPTH, 6 * D), f32) * 0.02,
        "mix_norm_gain": 1.0 + 0.05 * nrm(ks[4], (DEPTH, D), f32),
        "ffn_norm_gain": 1.0 + 0.05 * nrm(ks[5], (DEPTH, D), f32),
        "w_qkv": nrm(ks[6], (N_ATTN_LAYERS, D, QKV_DIM), f32) * D ** -0.5,
        "q_gain": 1.0 + 0.05 * nrm(ks[7], (N_ATTN_LAYERS, HEAD_DIM), f32),
        "k_gain": 1.0 + 0.05 * nrm(ks[8], (N_ATTN_LAYERS, HEAD_DIM), f32),
        "sinks": nrm(ks[9], (N_ATTN_LAYERS, N_Q_HEADS), f32),
        "w_o": nrm(ks[10], (N_ATTN_LAYERS, N_Q_HEADS * HEAD_DIM, D), f32) * (N_Q_HEADS * HEAD_DIM) ** -0.5,
        "pool_w": nrm(ks[11], (N_POOL_LAYERS, N_POOL_GROUPS, POOL_GROUP_DIM, POOL_GROUP_DIM), f32) * POOL_GROUP_DIM ** -0.5,
        "pool_scale": 1.0 + 0.1 * nrm(ks[12], (N_POOL_LAYERS, D), f32),
        "w_up": nrm(ks[13], (DEPTH, D, 2 * D_FF), f32) * D ** -0.5,
        "conv_w": nrm(ks[14], (DEPTH, CONV_WIDTH, 2 * D_FF), f32) * CONV_WIDTH ** -0.5,
        "conv_b": nrm(ks[15], (DEPTH, 2 * D_FF), f32) * 0.02,
        "w_down": nrm(ks[16], (DEPTH, D_FF, D), f32) * D_FF ** -0.5,
    }


def reference(x, c, mod_w, mod_b, mix_norm_gain, ffn_norm_gain, w_qkv, q_gain, k_gain,
              sinks, w_o, pool_w, pool_scale, w_up, conv_w, conv_b, w_down):
    c_act = jax.nn.silu(c)
    for i in range(DEPTH):
        mod = c_act @ mod_w[i] + mod_b[i]
        sh_m, sc_m, g_m, sh_f, sc_f, g_f = [m[:, None, :] for m in jnp.split(mod, 6, axis=-1)]

        h = rmsnorm(x, mix_norm_gain[i]) * (1.0 + sc_m) + sh_m
        if i % N_MIXERS == 0:
            a = i // N_MIXERS
            y = swa_sink_attention(h, w_qkv[a], q_gain[a], k_gain[a], sinks[a], w_o[a])
        else:
            p = i // N_MIXERS
            y = multiscale_pool_mixer(h, pool_w[p], pool_scale[p])
        x = x + g_m * y

        h = rmsnorm(x, ffn_norm_gain[i]) * (1.0 + sc_f) + sh_f
        x = x + g_f * conv_glu_ffn(h, w_up[i], conv_w[i], conv_b[i], w_down[i])
    return x
```

```cpp
#include <hip/hip_runtime.h>
#include <hip/hip_cooperative_groups.h>
#include <cstdio>
#include <cstdint>
namespace cg = cooperative_groups;

namespace pg8 {
#define PG8_LAS __attribute__((address_space(3)))
typedef unsigned short bf16_t;
typedef short bf16x8 __attribute__((ext_vector_type(8)));
typedef float f32x4 __attribute__((ext_vector_type(4)));
typedef unsigned u32x4 __attribute__((ext_vector_type(4)));
constexpr int BM = 256, BK = 64, HALF = 128, HTB = HALF * BK * 2  , STAGE_BYTES = 8 * HTB, NXCD = 8, WGM = 8;

__host__ __device__ __forceinline__ int lds_byte(int r, int c) { const int st = (r >> 4) * 2 + (c >> 5), rr = r & 15, cc = c & 31, ob = rr * 64 + cc * 2; return st * 1024 + (ob ^ (((ob >> 9) & 1) << 5)); }
__host__ __device__ __forceinline__ void stage_rc(int b, int& R, int& C) { const int st = b / 1024, sb = b % 1024, swz = sb ^ (((sb >> 9) & 1) << 5); R = (st >> 1) * 16 + swz / 64; C = (st & 1) * 32 + (swz % 64) / 2; }
__host__ __device__ __forceinline__ int perm32(int rho) { const int n = rho >> 4, i = rho & 15; return 8 * (i >> 2) + 4 * n + (i & 3); }

struct Unit { int pm, pn; };
struct Gemm { const bf16_t* A; const bf16_t* Bt; int lda, ldb, K, a_pn_off; };

struct StaticOrder {
    int nM, nN, nwg, G, c;
    __host__ __device__ void init(int M, int N, int G_, int c_) { nM = M / BM; nN = N / BM; nwg = nM * nN; G = G_; c = c_; }
    __host__ __device__ __forceinline__ bool next(int i, Unit& u) const {
        const long L = (long)i * G + c; if (L >= nwg) return false;
        int wgid = (int)L; { const int q = nwg / NXCD, r = nwg % NXCD, xcd = wgid % NXCD, off = wgid / NXCD; wgid = (xcd < r ? xcd * (q + 1) : r * (q + 1) + (xcd - r) * q) + off; }
        const int nig = WGM * nN, gid = wgid / nig, fm = gid * WGM, gsz = (nM - fm) < WGM ? (nM - fm) : WGM;
        u.pm = fm + ((wgid % nig) % gsz); u.pn = (wgid % nig) / gsz; return true;
    }
    __device__ __forceinline__ void a_ready(const Unit&) const {}
    __device__ __forceinline__ void done(const Unit&) const {}
};

__device__ __forceinline__ unsigned cvt_pk_bf16(float lo, float hi) { unsigned r; asm volatile("v_cvt_pk_bf16_f32 %0, %1, %2" : "=v"(r) : "v"(lo), "v"(hi)); return r; }
template <int CTRL> __device__ __forceinline__ float dppf(float v) { return __builtin_bit_cast(float, __builtin_amdgcn_update_dpp(0, __builtin_bit_cast(int, v), CTRL, 0xf, 0xf, true)); }
__device__ __forceinline__ float silu_f(float g) { return g * __builtin_amdgcn_rcpf(1.0f + __builtin_amdgcn_exp2f(-1.4426950408889634f * g)); }


struct EpiBf16 {
    static constexpr bool PERM = true, AFTER_DRAIN = false;
    bf16_t* O; int ldc;
    __device__ __forceinline__ void prefetch(const Unit&, int, int, int) const {}
    __device__ __forceinline__ void operator()(f32x4 (&acc)[2][2][4][2], const Unit& u, int wr, int wc, int fr, int fq, int wid, int lane, int ui) const {
        const int row0 = u.pm * BM + wr * 64 + fr, col0 = u.pn * BM + wc * 32 + 8 * fq;
#pragma unroll
        for (int ai = 0; ai < 2; ++ai)
#pragma unroll
            for (int m = 0; m < 4; ++m) { bf16_t* rowp = O + (size_t)(row0 + ai * HALF + m * 16) * ldc + col0;
#pragma unroll
                for (int bj = 0; bj < 2; ++bj) { const f32x4 v0 = acc[ai][bj][m][0], v1 = acc[ai][bj][m][1];
                    u32x4 w; w.x = cvt_pk_bf16(v0[0], v0[1]); w.y = cvt_pk_bf16(v0[2], v0[3]); w.z = cvt_pk_bf16(v1[0], v1[1]); w.w = cvt_pk_bf16(v1[2], v1[3]);
                    *(u32x4*)(rowp + bj * HALF) = w; } }
    }
};

template <bool WA, bool WS, bool BB  , bool OB  >
struct EpiRes {
    static constexpr bool PERM = true, AFTER_DRAIN = false, NTB = !BB || !OB;
    const void* base; void* out; const float* gate  ; const float* cscale  ;
    bf16_t* An; const float* gmul  ; float* ss  ;
    __device__ __forceinline__ void prefetch(const Unit&, int, int, int) const {}
    __device__ __forceinline__ void operator()(f32x4 (&acc)[2][2][4][2], const Unit& u, int wr, int wc, int fr, int fq, int wid, int lane, int ui) const {
        const int col0 = u.pn * BM + wc * 32 + 8 * fq; const int b = u.pm >> 5;
        f32x4 gv[2][2];
#pragma unroll
        for (int bj = 0; bj < 2; ++bj)
#pragma unroll
            for (int n = 0; n < 2; ++n) { const int c = col0 + bj * HALF + n * 4; f32x4 g = *(const f32x4*)(gate + (size_t)b * 6144 + c); if (cscale) g = g * *(const f32x4*)(cscale + c); gv[bj][n] = g; }
        constexpr int NB = (WA && BB) ? 1 : 2;
#pragma unroll
        for (int hq_ = 0; hq_ < 8 / NB; ++hq_) {
            const int ai = (hq_ * NB) >> 2, m0 = (hq_ * NB) & 3;
            const int rowb = u.pm * BM + ai * HALF + wr * 64 + fr;
            f32x4 pre[NB][2][2]; u32x4 preb[NB][2];
#pragma unroll
            for (int mm = 0; mm < NB; ++mm)
#pragma unroll
                for (int bj = 0; bj < 2; ++bj) {
                    const size_t o_ = (size_t)(rowb + (m0 + mm) * 16) * 1024 + col0 + bj * HALF;
                    if (BB) preb[mm][bj] = NTB ? __builtin_nontemporal_load((const u32x4*)((const bf16_t*)base + o_)) : *(const u32x4*)((const bf16_t*)base + o_);
                    else { pre[mm][bj][0] = NTB ? __builtin_nontemporal_load((const f32x4*)((const float*)base + o_)) : *(const f32x4*)((const float*)base + o_);
                           pre[mm][bj][1] = NTB ? __builtin_nontemporal_load((const f32x4*)((const float*)base + o_ + 4)) : *(const f32x4*)((const float*)base + o_ + 4); } }
            asm volatile("" ::: "memory");
            float sq[NB];
#pragma unroll
            for (int mm = 0; mm < NB; ++mm) { sq[mm] = 0.f;
#pragma unroll
                for (int bj = 0; bj < 2; ++bj) {
                    if (BB) { const u32x4 w = preb[mm][bj];
                        pre[mm][bj][0] = (f32x4){__uint_as_float(w.x << 16), __uint_as_float(w.x & 0xffff0000u), __uint_as_float(w.y << 16), __uint_as_float(w.y & 0xffff0000u)};
                        pre[mm][bj][1] = (f32x4){__uint_as_float(w.z << 16), __uint_as_float(w.z & 0xffff0000u), __uint_as_float(w.w << 16), __uint_as_float(w.w & 0xffff0000u)}; }
#pragma unroll
                    for (int n = 0; n < 2; ++n) { const f32x4 o = pre[mm][bj][n] + gv[bj][n] * acc[ai][bj][m0 + mm][n]; acc[ai][bj][m0 + mm][n] = o;
                        if (WS) sq[mm] += (o[0] * o[0] + o[1] * o[1]) + (o[2] * o[2] + o[3] * o[3]); } } }
            asm volatile("" ::: "memory");
#pragma unroll
            for (int mm = 0; mm < NB; ++mm) { const int m = m0 + mm; const size_t off = (size_t)(rowb + m * 16) * 1024 + col0;
#pragma unroll
                for (int bj = 0; bj < 2; ++bj) {
                    if (OB) { const f32x4 a0 = acc[ai][bj][m][0], a1 = acc[ai][bj][m][1]; u32x4 w; w.x = cvt_pk_bf16(a0[0], a0[1]); w.y = cvt_pk_bf16(a0[2], a0[3]); w.z = cvt_pk_bf16(a1[0], a1[1]); w.w = cvt_pk_bf16(a1[2], a1[3]);
                        *(u32x4*)((bf16_t*)out + off + bj * HALF) = w; }
                    else {
#pragma unroll
                        for (int n = 0; n < 2; ++n) __builtin_nontemporal_store(acc[ai][bj][m][n], (f32x4*)((float*)out + off + bj * HALF + n * 4)); }
                }
                if (WS) { float q = sq[mm]; q += __shfl_xor(q, 16); q += __shfl_xor(q, 32); if (fq == 0) atomicAdd(ss + rowb + m * 16, q); } }
            asm volatile("" ::: "memory");
        }
        if (WA) {
            f32x4 gm[2][2];
#pragma unroll
            for (int bj = 0; bj < 2; ++bj)
#pragma unroll
                for (int n = 0; n < 2; ++n) gm[bj][n] = *(const f32x4*)(gmul + (size_t)b * 1024 + col0 + bj * HALF + n * 4);
#pragma unroll
            for (int ai = 0; ai < 2; ++ai)
#pragma unroll
                for (int m = 0; m < 4; ++m) { const size_t off = (size_t)(u.pm * BM + ai * HALF + wr * 64 + fr + m * 16) * 1024 + col0;
#pragma unroll
                    for (int bj = 0; bj < 2; ++bj) { const f32x4 a0 = acc[ai][bj][m][0] * gm[bj][0], a1 = acc[ai][bj][m][1] * gm[bj][1]; u32x4 w; w.x = cvt_pk_bf16(a0[0], a0[1]); w.y = cvt_pk_bf16(a0[2], a0[3]); w.z = cvt_pk_bf16(a1[0], a1[1]); w.w = cvt_pk_bf16(a1[2], a1[3]);
                        *(u32x4*)(An + off + bj * HALF) = w; } }
        }
    }
};

struct EpiUp {
    static constexpr bool PERM = true, AFTER_DRAIN = false;
    bf16_t* act; const float* cw  ; const float* cb  ; float* halo; float* part; PG8_LAS unsigned char* xl  ;
    const float* ss  ; const float* cvec  ;
    __device__ __forceinline__ void prefetch(const Unit& u, int ui, int wid, int lane) const {
        PG8_LAS float* wl = (PG8_LAS float*)(xl + 8192 + 256) + (ui & 1) * 1536;
        const int t = wid * 64 + lane, c = t & 255, hi_ = t >> 8;
        const int gcol = (c >> 7) * 2816 + u.pn * HALF + (c & 127);
        const float* s0 = cw + (size_t)hi_ * 5632 + gcol;
        const float* s1 = hi_ == 0 ? cw + 2 * 5632 + gcol : cb + gcol;
        const float* s2 = hi_ == 0 ? ss + u.pm * BM + c : cvec + (size_t)(u.pm >> 5) * 5632 + u.pn * BM + c;
        __builtin_amdgcn_global_load_lds((const unsigned*)s0, (PG8_LAS unsigned*)(wl + wid * 64), 4, 0, 0);
        __builtin_amdgcn_global_load_lds((const unsigned*)s1, (PG8_LAS unsigned*)(wl + 512 + wid * 64), 4, 0, 0);
        __builtin_amdgcn_global_load_lds((const unsigned*)s2, (PG8_LAS unsigned*)(wl + 1024 + wid * 64), 4, 0, 0);
    }
    __device__ __forceinline__ void operator()(f32x4 (&acc)[2][2][4][2], const Unit& u, int wr, int wc, int fr, int fq, int wid, int lane, int ui) const {
        const int cbase = wc * 32 + 8 * fq;
        PG8_LAS float* wl = (PG8_LAS float*)(xl + 8192 + 256) + (ui & 1) * 1536;
        asm volatile("" ::: "memory");
        {
            f32x4 cv[2][2];
#pragma unroll
            for (int bj = 0; bj < 2; ++bj)
#pragma unroll
                for (int n = 0; n < 2; ++n) cv[bj][n] = *(const PG8_LAS f32x4*)(wl + 5 * 256 + bj * HALF + cbase + 4 * n);
#pragma unroll
            for (int ai = 0; ai < 2; ++ai)
#pragma unroll
                for (int m = 0; m < 4; ++m) { const float rs = __builtin_amdgcn_rsqf(wl[4 * 256 + ai * HALF + wr * 64 + m * 16 + fr] * (1.0f / 1024.0f) + 1e-6f);
#pragma unroll
                    for (int bj = 0; bj < 2; ++bj)
#pragma unroll
                        for (int n = 0; n < 2; ++n) acc[ai][bj][m][n] = acc[ai][bj][m][n] * rs + cv[bj][n]; }
        }
        if (fr >= 14) {
#pragma unroll
            for (int ai = 0; ai < 2; ++ai)
#pragma unroll
                for (int bj = 0; bj < 2; ++bj)
#pragma unroll
                    for (int n = 0; n < 2; ++n) *(PG8_LAS f32x4*)(xl + ((((ai * 2 + wr) * 2 + (fr - 14)) * 256) + bj * HALF + cbase + 4 * n) * 4) = acc[ai][bj][3][n];
            if (wr == 1) {
#pragma unroll
                for (int bj = 0; bj < 2; ++bj)
#pragma unroll
                    for (int n = 0; n < 2; ++n) *(f32x4*)(halo + ((size_t)(u.pm * 2 + (fr - 14)) * 5632 + bj * 2816 + u.pn * HALF + cbase + 4 * n)) = acc[1][bj][3][n];
            }
        }
        asm volatile("s_waitcnt lgkmcnt(0)" ::: "memory"); __builtin_amdgcn_s_barrier(); asm volatile("" ::: "memory");
#pragma unroll
        for (int n = 0; n < 2; ++n) {
            const int j0 = u.pn * HALF + cbase + 4 * n;
#pragma unroll
            for (int ai = 0; ai < 2; ++ai) {
                const int blk = ai * 2 + wr;
                const bool first = (blk == 0 && fr < 2);
#pragma unroll
                for (int bj = 1; bj >= 0; --bj) {
                    const PG8_LAS float* wp = wl + bj * HALF + cbase + 4 * n;
                    const f32x4 w0 = *(const PG8_LAS f32x4*)(wp), w1 = *(const PG8_LAS f32x4*)(wp + 256), w2 = *(const PG8_LAS f32x4*)(wp + 512), bb = *(const PG8_LAS f32x4*)(wp + 768);
                    f32x4 V = (f32x4){0.f, 0.f, 0.f, 0.f};
                    if (blk > 0 && fr >= 14) V = *(const PG8_LAS f32x4*)(xl + ((((blk - 1) * 2 + (fr - 14)) * 256) + bj * HALF + cbase + 4 * n) * 4);
                    asm volatile("s_nop 4" ::: "memory");
#pragma unroll
                    for (int m = 3; m >= 0; --m) {
                        const f32x4 cur = acc[ai][bj][m][n];
                        const f32x4 prv = m > 0 ? acc[ai][bj][m > 0 ? m - 1 : 0][n] : V;
                        f32x4 res; const f32x4 r4 = bb + w2 * cur;
#pragma unroll
                        for (int e = 0; e < 4; ++e) {
                            float r = r4[e];
                            const float c_ = cur[e], p_ = prv[e], w1_ = w1[e], w0_ = w0[e];
                            asm volatile("v_fmac_f32_dpp %0, %1, %2 row_shr:1 row_mask:0xf bank_mask:0xf" : "+v"(r) : "v"(c_), "v"(w1_));
                            asm volatile("v_fmac_f32_dpp %0, %1, %2 row_shr:2 row_mask:0xf bank_mask:0xf" : "+v"(r) : "v"(c_), "v"(w0_));
                            asm volatile("v_fmac_f32_dpp %0, %1, %2 row_shl:15 row_mask:0xf bank_mask:0xf" : "+v"(r) : "v"(p_), "v"(w1_));
                            asm volatile("v_fmac_f32_dpp %0, %1, %2 row_shl:14 row_mask:0xf bank_mask:0xf" : "+v"(r) : "v"(p_), "v"(w0_));
                            res[e] = r;
                        }
                        if (m == 0 && first) *(f32x4*)(part + (size_t)(u.pm * 2 + fr) * 5632 + bj * 2816 + j0) = res;
                        if (bj == 0) {
                            const f32x4 vv = acc[ai][1][m][n];
                            const f32x4 ng = res * (-1.4426950408889634f); f32x4 ex;
#pragma unroll
                            for (int e = 0; e < 4; ++e) ex[e] = __builtin_amdgcn_exp2f(ng[e]);
                            const f32x4 dn = ex + 1.0f; f32x4 rc;
#pragma unroll
                            for (int e = 0; e < 4; ++e) rc[e] = __builtin_amdgcn_rcpf(dn[e]);
                            res = (res * vv) * rc;
                        }
                        acc[ai][bj][m][n] = res;
                        asm volatile("" : "+v"(acc[ai][bj][m][n]));
                    }
                }
            }
        }
        const int row0 = u.pm * BM + wr * 64 + fr;
#pragma unroll
        for (int ai = 0; ai < 2; ++ai)
#pragma unroll
            for (int m = 0; m < 4; ++m) { const f32x4 v0 = acc[ai][0][m][0], v1 = acc[ai][0][m][1];
                u32x4 w; w.x = cvt_pk_bf16(v0[0], v0[1]); w.y = cvt_pk_bf16(v0[2], v0[3]); w.z = cvt_pk_bf16(v1[0], v1[1]); w.w = cvt_pk_bf16(v1[2], v1[3]);
                *(u32x4*)(act + (size_t)(row0 + ai * HALF + m * 16) * 2816 + u.pn * HALF + cbase) = w; }
    }
};

template <class Epi, class Sched, bool ALIGN_EPI = false, bool SP2 = false>
__device__ __forceinline__ void gemm_phase(PG8_LAS unsigned char* lds, const Gemm g, const Sched& S, const Epi& E) {
    const int tid = threadIdx.x, wid = __builtin_amdgcn_readfirstlane(tid >> 6), lane = tid & 63, wr = wid >> 2, wc = wid & 3, fr = lane & 15, fq = lane >> 4;
    const int K = g.K, nt = K / BK;
    unsigned voffA[2], voffB[2];
#pragma unroll
    for (int i = 0; i < 2; ++i) { int R, C; stage_rc(tid * 16 + i * 8192, R, C); const int Rb = Epi::PERM ? ((R & ~31) + perm32(R & 31)) : R;
        voffA[i] = (unsigned)(R * g.lda + C) * 2u; voffB[i] = (unsigned)(Rb * g.ldb + C) * 2u; }
    const size_t kstep = (size_t)(BK * 2);
    const size_t hsA = (size_t)HALF * g.lda * 2, hsB = (size_t)HALF * g.ldb * 2;
    const size_t tsA = 2 * hsA, tsB = 2 * hsB, pnA = (size_t)g.a_pn_off * 2;
    const unsigned ldsw = (unsigned)wid * 1024u;
    const int aoff = lds_byte(wr * 64 + fr, fq * 8), boff = lds_byte(wc * 32 + fr, fq * 8);
#define PG8_SA(b, h) (((b) * 2 + (h)) * HTB)
#define PG8_SB(b, h) ((4 + (b) * 2 + (h)) * HTB)
#define PG8_STAGE(bufoff, gbase, voff) do { _Pragma("unroll") for (int _i = 0; _i < 2; ++_i) \
        __builtin_amdgcn_global_load_lds((const unsigned*)((const char*)(gbase) + (voff)[_i]), (PG8_LAS unsigned*)(lds + (bufoff) + ldsw + _i * 8192), 16, 0, 0); } while (0)
#define PG8_LDA(dst, b, h) do { _Pragma("unroll") for (int m = 0; m < 4; ++m) _Pragma("unroll") for (int k = 0; k < 2; ++k) dst[m][k] = *(const PG8_LAS bf16x8*)(lds + PG8_SA(b, h) + aoff + m * 2048 + k * 1024); } while (0)
#define PG8_LDB(dst, b, h) do { _Pragma("unroll") for (int n = 0; n < 2; ++n) _Pragma("unroll") for (int k = 0; k < 2; ++k) dst[n][k] = *(const PG8_LAS bf16x8*)(lds + PG8_SB(b, h) + boff + n * 2048 + k * 1024); } while (0)
#define PG8_MMA(ai, bj, At, Bt) do { __builtin_amdgcn_s_setprio(1); _Pragma("unroll") for (int m = 0; m < 4; ++m) _Pragma("unroll") for (int n = 0; n < 2; ++n) _Pragma("unroll") for (int k = 0; k < 2; ++k) \
        acc[ai][bj][m][n] = __builtin_amdgcn_mfma_f32_16x16x32_bf16(Bt[n][k], At[m][k], acc[ai][bj][m][n], 0, 0, 0); __builtin_amdgcn_s_setprio(0); } while (0)
#define PG8_WAIT_V(n) asm volatile("s_waitcnt vmcnt(" #n ")" ::: "memory")
#define PG8_WAIT_L(n) asm volatile("s_waitcnt lgkmcnt(" #n ")" ::: "memory")
#define PG8_BAR __builtin_amdgcn_s_barrier()
#define PG8_SCHED __builtin_amdgcn_sched_barrier(0)
    Unit cur, nxt; int ui = 0;
    if (!S.next(0, cur)) return;
    f32x4 acc[2][2][4][2];
#pragma unroll
    for (int a = 0; a < 2; ++a)
#pragma unroll
        for (int b = 0; b < 2; ++b)
#pragma unroll
            for (int m = 0; m < 4; ++m)
#pragma unroll
                for (int n = 0; n < 2; ++n) acc[a][b][m][n] = (f32x4){0.f, 0.f, 0.f, 0.f};
    bf16x8 At[4][2], B0[2][2], B1[2][2];
    const char* cA = (const char*)g.A + (size_t)cur.pm * tsA + (size_t)cur.pn * pnA; const char* cB = (const char*)g.Bt + (size_t)cur.pn * tsB;
    S.a_ready(cur);
    E.prefetch(cur, 0, wid, lane);
    if constexpr (SP2) {
        PG8_STAGE(PG8_SB(0, 0), cB, voffB); PG8_STAGE(PG8_SB(0, 1), cB + hsB, voffB); PG8_STAGE(PG8_SA(0, 0), cA, voffA); PG8_STAGE(PG8_SA(0, 1), cA + hsA, voffA);
        if (wr == 1) PG8_BAR;
        PG8_WAIT_V(2); PG8_BAR;
        PG8_STAGE(PG8_SB(1, 0), cB + kstep, voffB); PG8_STAGE(PG8_SA(1, 0), cA + kstep, voffA); PG8_STAGE(PG8_SB(1, 1), cB + hsB + kstep, voffB);
        PG8_WAIT_V(6); PG8_BAR;
    } else {
        PG8_STAGE(PG8_SB(0, 0), cB, voffB); PG8_STAGE(PG8_SA(0, 0), cA, voffA); PG8_STAGE(PG8_SB(0, 1), cB + hsB, voffB); PG8_STAGE(PG8_SA(0, 1), cA + hsA, voffA);
        if (wr == 1) PG8_BAR;
        PG8_WAIT_V(4); PG8_BAR;
        PG8_STAGE(PG8_SB(1, 0), cB + kstep, voffB); PG8_STAGE(PG8_SA(1, 0), cA + kstep, voffA); PG8_STAGE(PG8_SB(1, 1), cB + hsB + kstep, voffB);
        PG8_WAIT_V(6); PG8_BAR;
    }
    for (;;) {
        const bool has_next = S.next(ui + 1, nxt);
        const char* nA = has_next ? (const char*)g.A + (size_t)nxt.pm * tsA + (size_t)nxt.pn * pnA : cA; const char* nB = has_next ? (const char*)g.Bt + (size_t)nxt.pn * tsB : cB;
        for (int t = 0; t < nt; t += 2) {
            const bool last = (t == nt - 2);
            const char* a1 = cA + (size_t)(t + 1) * kstep;
            const char* a2 = last ? nA : cA + (size_t)(t + 2) * kstep; const char* b2 = last ? nB : cB + (size_t)(t + 2) * kstep;
            const char* a3 = a2 + kstep; const char* b3 = b2 + kstep;
            if (last && has_next) S.a_ready(nxt);
            if constexpr (SP2) {
            PG8_LDB(B0, 0, 0); PG8_LDB(B1, 0, 1); PG8_SCHED; PG8_LDA(At, 0, 0); PG8_STAGE(PG8_SA(1, 1), a1 + hsA, voffA);
            PG8_WAIT_V(8); PG8_WAIT_L(0); PG8_BAR; PG8_MMA(0, 0, At, B0); PG8_MMA(0, 1, At, B1); PG8_BAR; PG8_SCHED;
            PG8_LDA(At, 0, 1); PG8_STAGE(PG8_SB(0, 0), b2, voffB); PG8_STAGE(PG8_SB(0, 1), b2 + hsB, voffB); PG8_STAGE(PG8_SA(0, 0), a2, voffA);
            PG8_WAIT_V(8); PG8_WAIT_L(0); PG8_BAR; PG8_MMA(1, 0, At, B0); PG8_MMA(1, 1, At, B1); PG8_BAR; PG8_SCHED;
            PG8_LDB(B0, 1, 0); PG8_LDB(B1, 1, 1); PG8_SCHED; PG8_LDA(At, 1, 0); PG8_STAGE(PG8_SA(0, 1), a2 + hsA, voffA);
            PG8_WAIT_V(8); PG8_WAIT_L(0); PG8_BAR; PG8_MMA(0, 0, At, B0); PG8_MMA(0, 1, At, B1); PG8_BAR; PG8_SCHED;
            PG8_LDA(At, 1, 1); PG8_STAGE(PG8_SB(1, 0), b3, voffB); PG8_STAGE(PG8_SB(1, 1), b3 + hsB, voffB); PG8_STAGE(PG8_SA(1, 0), a3, voffA);
            PG8_WAIT_V(8); PG8_WAIT_L(0); PG8_BAR; PG8_MMA(1, 0, At, B0); PG8_MMA(1, 1, At, B1); PG8_BAR; PG8_SCHED;
            } else {
            PG8_LDB(B0, 0, 0); PG8_SCHED; PG8_LDA(At, 0, 0); PG8_STAGE(PG8_SA(1, 1), a1 + hsA, voffA);
            PG8_WAIT_L(8); PG8_BAR; PG8_WAIT_L(0); PG8_MMA(0, 0, At, B0); PG8_BAR; PG8_SCHED;
            PG8_LDB(B1, 0, 1); PG8_STAGE(PG8_SB(0, 0), b2, voffB);
            PG8_BAR; PG8_WAIT_L(0); PG8_MMA(0, 1, At, B1); PG8_BAR;
            PG8_LDA(At, 0, 1); PG8_STAGE(PG8_SA(0, 0), a2, voffA);
            PG8_BAR; PG8_WAIT_L(0); PG8_MMA(1, 0, At, B0); PG8_BAR; PG8_SCHED;
            PG8_STAGE(PG8_SB(0, 1), b2 + hsB, voffB);
            PG8_WAIT_V(6); PG8_BAR; PG8_MMA(1, 1, At, B1); PG8_BAR;
            PG8_LDB(B0, 1, 0); PG8_SCHED; PG8_LDA(At, 1, 0); PG8_STAGE(PG8_SA(0, 1), a2 + hsA, voffA);
            PG8_WAIT_L(8); PG8_BAR; PG8_WAIT_L(0); PG8_MMA(0, 0, At, B0); PG8_BAR; PG8_SCHED;
            PG8_LDB(B1, 1, 1); PG8_STAGE(PG8_SB(1, 0), b3, voffB);
            PG8_BAR; PG8_WAIT_L(0); PG8_MMA(0, 1, At, B1); PG8_BAR;
            PG8_LDA(At, 1, 1); PG8_STAGE(PG8_SA(1, 0), a3, voffA);
            PG8_BAR; PG8_WAIT_L(0); PG8_MMA(1, 0, At, B0); PG8_BAR; PG8_SCHED;
            PG8_STAGE(PG8_SB(1, 1), b3 + hsB, voffB);
            PG8_WAIT_V(6); PG8_BAR; PG8_MMA(1, 1, At, B1); PG8_BAR;
            }
        }
        if constexpr (ALIGN_EPI) { if (wr == 0) PG8_BAR; }
        if constexpr (!Epi::AFTER_DRAIN) { E(acc, cur, wr, wc, fr, fq, wid, lane, ui); S.done(cur); }
        if (!has_next) break;
#pragma unroll
        for (int a = 0; a < 2; ++a)
#pragma unroll
            for (int b = 0; b < 2; ++b)
#pragma unroll
                for (int m = 0; m < 4; ++m)
#pragma unroll
                    for (int n = 0; n < 2; ++n) acc[a][b][m][n] = (f32x4){0.f, 0.f, 0.f, 0.f};
        cur = nxt; cA = nA; cB = nB; ++ui;
        E.prefetch(cur, ui, wid, lane);
        if constexpr (ALIGN_EPI) { if (wr == 1) PG8_BAR; }
    }
    PG8_WAIT_V(0);
    if constexpr (!ALIGN_EPI) { if (wr == 0) PG8_BAR; }
    PG8_BAR;
    if constexpr (Epi::AFTER_DRAIN) { E.fused(acc, cur, wr, wc, fr, fq, lds, wid, lane); S.done(cur); }
#undef PG8_SA
#undef PG8_SB
#undef PG8_STAGE
#undef PG8_LDA
#undef PG8_LDB
#undef PG8_MMA
#undef PG8_WAIT_V
#undef PG8_WAIT_L
#undef PG8_BAR
#undef PG8_SCHED
}
}

#define LAS __attribute__((address_space(3)))
typedef unsigned short bf16;
typedef float f32x4 __attribute__((ext_vector_type(4)));
typedef float f32x16 __attribute__((ext_vector_type(16)));
typedef short bf16x8 __attribute__((ext_vector_type(8)));
typedef short s16x4 __attribute__((ext_vector_type(4)));
typedef unsigned u32x4 __attribute__((ext_vector_type(4)));
typedef unsigned u32x2 __attribute__((ext_vector_type(2)));

constexpr int NWAVES = 8, NT = 512;
constexpr int SEQ = 8192, DM = 1024, M = 2 * SEQ, NQKV = 1536, DFF = 2816, NUP = 5632;
constexpr size_t MiB = 1u << 20;
constexpr size_t WS_CTL = 0, CTL_ZERO_BYTES = 65536;
constexpr size_t WS_MODP = 1 * MiB;
constexpr size_t WS_MODF = WS_MODP + 8 * 2 * 2 * 6144 * 4;
constexpr size_t WS_ROPE = 2 * MiB;
constexpr size_t WS_SS = 2 * MiB + 512 * 1024;
constexpr size_t WS_GM = 2 * MiB + 768 * 1024;
constexpr size_t WS_CVEC = 2 * MiB + 832 * 1024;
constexpr size_t WS_WQKV = 3 * MiB, WS_WO = 6 * MiB, WS_WPOOL = 8 * MiB, WS_WUP = 9 * MiB, WS_WDN = 31 * MiB;
constexpr size_t WS_HALO = 42 * MiB, WS_PART = 45 * MiB;
constexpr size_t WS_X = 48 * MiB;
constexpr size_t WS_H = 112 * MiB;
constexpr size_t WS_QKV = 144 * MiB;
constexpr size_t WS_ATT = 192 * MiB;
constexpr size_t WS_ACT = 144 * MiB;
constexpr size_t WS_END = 232 * MiB;
constexpr int CW_BAR = 1024;
constexpr int RING_BYTES = 131072, XL_OFF = 131072, MISC_OFF = XL_OFF + 8192, LDS_BYTES = 155648;
constexpr float LOG2E = 1.4426950408889634f, NORM_EPS = 1e-6f;

__device__ __forceinline__ unsigned pk2(float lo, float hi) { return pg8::cvt_pk_bf16(lo, hi); }
__device__ __forceinline__ float bf_lo(unsigned u) { return __uint_as_float(u << 16); }
__device__ __forceinline__ float bf_hi(unsigned u) { return __uint_as_float(u & 0xffff0000u); }
__device__ __forceinline__ float wave_sum(float v) {
#pragma unroll
    for (int o = 1; o < 64; o <<= 1) v += __shfl_xor(v, o);
    return v;
}

#define XB_TMO      128
#define XB_XCNT(j)  (256  + 64 * (j))
#define XB_XSUB(j)  (1280 + 64 * (j))
#define XB_XGEN(j)  (2304 + 64 * (j))
#define XB_TOP      3328
#define XB_TOPGEN   3392
#define XCD_BAR_WORDS 3456
#define XB_SPIN_CAP (1u << 20)
__device__ __forceinline__ unsigned xb_ld(unsigned* p)              { return __hip_atomic_load(p, __ATOMIC_RELAXED, __HIP_MEMORY_SCOPE_AGENT); }
__device__ __forceinline__ unsigned xb_add(unsigned* p, unsigned v) { return __hip_atomic_fetch_add(p, v, __ATOMIC_RELAXED, __HIP_MEMORY_SCOPE_AGENT); }
__device__ __forceinline__ unsigned xb_xcc_id() { return (unsigned)__builtin_amdgcn_s_getreg((3 << 11) | 20) & 0xFu; }
#define XB_SPIN(cond, bar) do { unsigned _sp = 0; while (cond) { __builtin_amdgcn_s_sleep(1); \
    if ((++_sp & 255u) == 0u) { if (xb_ld(&(bar)[XB_TMO])) break; if (_sp > XB_SPIN_CAP) { atomicAdd(&(bar)[XB_TMO], 1u); break; } } } } while (0)
struct XcdBarrier { unsigned* bar; unsigned x; volatile LAS unsigned* st; };
__device__ __forceinline__ XcdBarrier xcd_barrier_post(unsigned* bar, volatile LAS unsigned* st) {
    XcdBarrier b; b.bar = bar; b.x = xb_xcc_id(); b.st = st;
    if (threadIdx.x == 0) (void)xb_add(&bar[XB_XCNT(b.x)], 1u);
    return b;
}
__device__ __forceinline__ void xcd_barrier_complete(unsigned* bar, unsigned x, unsigned& nloc, unsigned& nx) {
    const unsigned G = gridDim.x * gridDim.y * gridDim.z;
    unsigned sum, cnt, mine, sp = 0u;
    for (;;) {
        sum = 0u; cnt = 0u; mine = 0u;
#pragma unroll
        for (unsigned j = 0; j < 16; ++j) { const unsigned c = xb_ld(&bar[XB_XCNT(j)]); sum += c; cnt += (c > 0u) ? 1u : 0u; mine = (j == x) ? c : mine; }
        if (sum == G) break;
        __builtin_amdgcn_s_sleep(1);
        if ((++sp & 255u) == 0u) { if (xb_ld(&bar[XB_TMO])) break; if (sp > XB_SPIN_CAP) { atomicAdd(&bar[XB_TMO], 1u); break; } }
    }
    nloc = mine > 0u ? mine : 1u; nx = cnt > 0u ? cnt : 1u;
}
__device__ __forceinline__ void xcd_barrier(const XcdBarrier& b) {
    asm volatile("s_waitcnt vmcnt(0)" ::: "memory");
    __syncthreads();
    if (threadIdx.x == 0) {
        unsigned* bar = b.bar;
        __builtin_amdgcn_s_waitcnt(0);
        unsigned nloc = b.st[0], nx = b.st[1];
        if (nloc == 0u) { xcd_barrier_complete(bar, b.x, nloc, nx); b.st[0] = nloc; b.st[1] = nx; }
        const unsigned old = xb_add(&bar[XB_XSUB(b.x)], 1u);
        const unsigned gen = old / nloc;
        if (old + 1u == (gen + 1u) * nloc) {
            __builtin_amdgcn_fence(__ATOMIC_RELEASE, "agent");
            asm volatile("s_waitcnt vmcnt(0)" ::: "memory");
            const unsigned og = xb_add(&bar[XB_TOP], 1u);
            const unsigned tg = og / nx;
            if (og + 1u == (tg + 1u) * nx) xb_add(&bar[XB_TOPGEN], 1u);
            else XB_SPIN(xb_ld(&bar[XB_TOPGEN]) == tg, bar);
            __builtin_amdgcn_fence(__ATOMIC_ACQUIRE, "agent");
            xb_add(&bar[XB_XGEN(b.x)], 1u);
            asm volatile("s_waitcnt vmcnt(0)" ::: "memory");
        } else {
            XB_SPIN(xb_ld(&bar[XB_XGEN(b.x)]) == gen, bar);
            __builtin_amdgcn_fence(__ATOMIC_ACQUIRE, "agent");
            asm volatile("s_waitcnt vmcnt(0)" ::: "memory");
        }
    }
    __syncthreads();
}

struct Ctx { LAS unsigned char* lds; int tid, lane, wave, G, vcu; unsigned char* ws; };

__device__ __forceinline__ void transpose_item(const float* W, int K, int N, bf16* WT, int k0, int n0, int dst_row0, LAS float* scr, int lane) {
    float tv[32];
#pragma unroll
    for (int i = 0; i < 32; ++i) tv[i] = __builtin_nontemporal_load(&W[(size_t)(k0 + 2 * i + (lane >> 5)) * N + n0 + (lane & 31)]);
#pragma unroll
    for (int i = 0; i < 32; ++i) scr[(2 * i + (lane >> 5)) * 33 + (lane & 31)] = tv[i];
    asm volatile("s_waitcnt lgkmcnt(0)" ::: "memory");
    const int c = lane & 7;
#pragma unroll
    for (int j = 0; j < 4; ++j) { const int n = (lane >> 3) + 8 * j; const LAS float* s = scr + (8 * c) * 33 + n;
        u32x4 o; o.x = pk2(s[0 * 33], s[1 * 33]); o.y = pk2(s[2 * 33], s[3 * 33]); o.z = pk2(s[4 * 33], s[5 * 33]); o.w = pk2(s[6 * 33], s[7 * 33]);
        *(u32x4*)(WT + (size_t)(dst_row0 + n) * K + k0 + 8 * c) = o; }
    asm volatile("s_waitcnt lgkmcnt(0)" ::: "memory");
}

__device__ __forceinline__ void ph_prologue(const Ctx& F, const float* const* in) {
    LAS float* cact = (LAS float*)(F.lds + XL_OFF);
    const float* c = in[1];
    for (int i = F.tid; i < 2048; i += NT) { const float v = c[i]; cact[i] = v / (1.0f + __expf(-v)); }
    __syncthreads();
    const int gw = F.vcu * NWAVES + F.wave, NGW = F.G * NWAVES;
    float* MODP = (float*)(F.ws + WS_MODP);
    typedef float f32x2_ __attribute__((ext_vector_type(2)));
    for (int it = gw; it < 768; it += NGW) {
        const int i = it / 384, r = it % 384, p = r / 48, cb = r % 48;
        const float* W = in[2] + (size_t)i * 1024 * 6144 + (size_t)(p * 128) * 6144 + cb * 128 + F.lane * 2;
        f32x2_ a0 = (f32x2_){0.f, 0.f}, a1 = a0;
#pragma unroll 64
        for (int k = 0; k < 128; ++k) { const f32x2_ w = __builtin_nontemporal_load((const f32x2_*)(W + (size_t)k * 6144)); const float c0 = cact[p * 128 + k], c1 = cact[1024 + p * 128 + k]; a0 += w * c0; a1 += w * c1; }
        *(f32x2_*)(MODP + ((size_t)((p * 2 + i) * 2 + 0)) * 6144 + cb * 128 + F.lane * 2) = a0;
        *(f32x2_*)(MODP + ((size_t)((p * 2 + i) * 2 + 1)) * 6144 + cb * 128 + F.lane * 2) = a1;
    }
    LAS float* scr = (LAS float*)(F.lds + F.wave * 16384);
    for (int it = (gw + NGW - (768 % NGW)) % NGW; it < 16 * 48; it += NGW) { const int kb = it / 48, nb = it % 48; transpose_item(in[6], 1024, 1536, (bf16*)(F.ws + WS_WQKV), 64 * kb, 32 * nb, 32 * nb, scr, F.lane); }
    { float* SS = (float*)(F.ws + WS_SS); for (int idx = F.vcu * NT + F.tid; idx < 3 * M; idx += F.G * NT) SS[idx] = 0.f; }
    float* rope = (float*)(F.ws + WS_ROPE);
    for (int idx = F.vcu * NT + F.tid; idx < 65536; idx += F.G * NT) {
        const int pos = idx >> 3, i = idx & 7;
        const float invf = i == 0 ? 1.0f : i == 1 ? 0.19392274474868576f : i == 2 ? 0.03760603093086393f : i == 3 ? 0.007292664737217109f : i == 4 ? 0.001414213562373095f : i == 5 ? 0.0002742481756762073f : i == 6 ? 5.318295896944988e-05f : 1.031338537721246e-05f;
        const float ang = (float)pos * invf;
        const float k = rintf(ang * 0.15915494309189535f);
        float r = fmaf(-k, 6.28125f, ang); r = fmaf(-k, 1.9353071795864769e-3f, r);
        rope[pos * 16 + i] = __cosf(r); rope[pos * 16 + 8 + i] = __sinf(r);
    }
}

__device__ __forceinline__ void convert_rest(const Ctx& F, const float* const* in, int w, int nw, int part) {
    LAS float* scr = (LAS float*)(F.lds + F.wave * 16384);
    const int gw = w * NWAVES + F.wave, NGW = nw * NWAVES;
    constexpr int I_WO = 16 * 32, I_POOL = 4 * 4 * 8, I_UP = 16 * 176, I_DN = 44 * 32;
    constexpr int NITEMS = I_WO + I_POOL + 2 * I_UP + 2 * I_DN;
    for (int it = gw; it < NITEMS; it += NGW) {
        int r = it;
        { int q = r; const bool l1 = (q >= I_WO + I_POOL + I_UP && q < I_WO + I_POOL + 2 * I_UP) || (q >= I_WO + I_POOL + 2 * I_UP);   if ((part == 1) != l1) continue; }
        if (r < I_WO) { const int kb = r / 32, nb = r % 32; transpose_item(in[10], 1024, 1024, (bf16*)(F.ws + WS_WO), 64 * kb, 32 * nb, 32 * nb, scr, F.lane); continue; } r -= I_WO;
        if (r < I_POOL) { const int g = r / 32, q = r % 32, kb = q / 8, nb = q % 8; transpose_item(in[11] + (size_t)g * 65536, 256, 256, (bf16*)(F.ws + WS_WPOOL) + (size_t)g * 65536, 64 * kb, 32 * nb, 32 * nb, scr, F.lane); continue; } r -= I_POOL;
        if (r < 2 * I_UP) { const int l = r / I_UP, q = r % I_UP, kb = q / 176, nb = q % 176, n0 = 32 * nb;
            const int dst = n0 < DFF ? (n0 / 128) * 256 + (n0 % 128) : ((n0 - DFF) / 128) * 256 + 128 + ((n0 - DFF) % 128);
            transpose_item(in[13] + (size_t)l * 1024 * NUP, 1024, NUP, (bf16*)(F.ws + WS_WUP) + (size_t)l * NUP * 1024, 64 * kb, n0, dst, scr, F.lane); continue; } r -= 2 * I_UP;
        { const int l = r / I_DN, q = r % I_DN, kb = q / 32, nb = q % 32;
            transpose_item(in[16] + (size_t)l * DFF * 1024, DFF, 1024, (bf16*)(F.ws + WS_WDN) + (size_t)l * 1024 * DFF, 64 * kb, 32 * nb, 32 * nb, scr, F.lane); }
    }
}

template <bool FROM_PART>
__device__ __forceinline__ void ph_norm(const Ctx& F, const float* X, const float* gain, const float* mod_b_layer, int layer, int chunk, bf16* H, const float* gain_ffn) {
    LAS float* gm = (LAS float*)F.lds; LAS float* sh = gm + 1024;
    const float* MODP = (const float*)(F.ws + WS_MODP); float* MODF = (float*)(F.ws + WS_MODF);
    if (FROM_PART) {
        for (int idx = F.vcu * NT + F.tid; idx < 2 * 2 * 6144; idx += F.G * NT) { const int i = idx / 12288, rem = idx % 12288, b = rem / 6144, col = rem % 6144;
            float t = ((const float*)mod_b_layer)[(size_t)(i - layer) * 6144 + col];
#pragma unroll
            for (int p = 0; p < 8; ++p) t += MODP[((size_t)((p * 2 + i) * 2 + b)) * 6144 + col];
            MODF[idx] = t; }
        float* GM = (float*)(F.ws + WS_GM);
        for (int idx = F.vcu * NT + F.tid; idx < 2 * 2 * 1024; idx += F.G * NT) { const int i = idx >> 11, b = (idx >> 10) & 1, c = idx & 1023;
            float t = ((const float*)mod_b_layer)[(size_t)(i - layer) * 6144 + 4 * 1024 + c];
#pragma unroll
            for (int p = 0; p < 8; ++p) t += MODP[((size_t)((p * 2 + i) * 2 + b)) * 6144 + 4 * 1024 + c];
            GM[idx] = gain_ffn[i * 1024 + c] * (1.0f + t); }
    }
    for (int rb = blockIdx.x; rb < 256; rb += F.G) {
        const int b = rb >> 7;
        __syncthreads();
        for (int c = F.tid; c < 1024; c += NT) {
            float t, s;
            if (FROM_PART) { t = mod_b_layer[chunk * 1024 + c]; s = mod_b_layer[(chunk + 1) * 1024 + c];
#pragma unroll
                for (int p = 0; p < 8; ++p) { const float* mp = MODP + ((size_t)((p * 2 + layer) * 2 + b)) * 6144; t += mp[chunk * 1024 + c]; s += mp[(chunk + 1) * 1024 + c]; } }
            else { const float* mf = MODF + (size_t)(layer * 2 + b) * 6144; t = mf[chunk * 1024 + c]; s = mf[(chunk + 1) * 1024 + c]; }
            gm[c] = gain[c] * (1.0f + s); sh[c] = t;
        }
        __syncthreads();
#pragma unroll 4
        for (int j = 0; j < 8; ++j) {
            const int row = rb * 64 + F.wave * 8 + j;
            const f32x4* xr = (const f32x4*)(X + (size_t)row * 1024) + F.lane;
            f32x4 v[4]; float ss = 0.f;
#pragma unroll
            for (int q = 0; q < 4; ++q) { v[q] = FROM_PART ? __builtin_nontemporal_load(xr + 64 * q) : xr[64 * q]; ss += (v[q].x * v[q].x + v[q].y * v[q].y) + (v[q].z * v[q].z + v[q].w * v[q].w); }
            const float rstd = rsqrtf(wave_sum(ss) * (1.0f / 1024.0f) + NORM_EPS);
            u32x2* o8 = (u32x2*)(H + (size_t)row * 1024) + F.lane;
#pragma unroll
            for (int q = 0; q < 4; ++q) { const f32x4 g4 = *(const LAS f32x4*)(gm + 256 * q + 4 * F.lane), s4 = *(const LAS f32x4*)(sh + 256 * q + 4 * F.lane);
                const f32x4 h = v[q] * rstd * g4 + s4; u32x2 w; w.x = pk2(h.x, h.y); w.y = pk2(h.z, h.w); o8[64 * q] = w; }
        }
    }
}

template <int W>
__device__ __forceinline__ void pool_rows(const bf16* Xg, bf16* Dg, int t0, int half, const LAS float* rs, f32x4 g4, f32x4 s4) {
    f32x4 ring[W]; f32x4 sum = (f32x4){0.f, 0.f, 0.f, 0.f};
#pragma unroll
    for (int k = 0; k < W; ++k) ring[k] = (f32x4){0.f, 0.f, 0.f, 0.f};
#pragma unroll 1
    for (int c = 0; c < 3; ++c) {
        u32x2 xr[16];
#pragma unroll
        for (int i = 0; i < 16; ++i) { const int jj = 16 * c + i, t = t0 - 15 + 32 * half + jj; xr[i] = (u32x2){0u, 0u}; if (jj < 47 && t >= 0) xr[i] = *(const u32x2*)(Xg + (size_t)t * 1024); }
#pragma unroll
        for (int i = 0; i < 16; ++i) {
            const int jj = 16 * c + i, j = 32 * half + jj, t = t0 - 15 + j;
            if (jj < 47) {
                const f32x4 xv = (f32x4){bf_lo(xr[i].x), bf_hi(xr[i].x), bf_lo(xr[i].y), bf_hi(xr[i].y)};
                f32x4 h = xv * rs[j] * g4 + s4;
                if (t < 0) h = (f32x4){0.f, 0.f, 0.f, 0.f};
                sum = sum + h - ring[W - 1];
#pragma unroll
                for (int k = W - 1; k > 0; --k) ring[k] = ring[k - 1];
                ring[0] = h;
                if (jj >= 15) {
                    const float inv = 1.0f / (float)((t + 1) < W ? (t + 1) : W);
                    const f32x4 d = sum * inv - h;
                    u32x2 w; w.x = pk2(d.x, d.y); w.y = pk2(d.z, d.w);
                    *(u32x2*)(Dg + (size_t)t * 1024) = w;
                }
            }
        }
    }
}
__device__ __forceinline__ void ph_pooldiff(const Ctx& F, const bf16* X, const float* gain, int layer, bf16* D, const float* SSQ) {
    LAS float* gm = (LAS float*)F.lds; LAS float* sh = gm + 1024; LAS float* rs = sh + 1024;
    const float* MODF = (const float*)(F.ws + WS_MODF);
    for (int rb = blockIdx.x; rb < 256; rb += F.G) {
        const int b = rb >> 7, t0 = (rb & 127) * 64;
        __syncthreads();
        for (int c = F.tid; c < 1024; c += NT) { const float* mf = MODF + (size_t)(layer * 2 + b) * 6144; gm[c] = gain[c] * (1.0f + mf[1024 + c]); sh[c] = mf[c]; }
        for (int j = F.tid; j < 79; j += NT) { const int t = t0 - 15 + j; rs[j] = t >= 0 ? rsqrtf(SSQ[(size_t)b * SEQ + t] * (1.0f / 1024.0f) + NORM_EPS) : 0.f; }
        __syncthreads();
        const int g = F.wave & 3, half = F.wave >> 2;
        const f32x4 g4 = *(const LAS f32x4*)(gm + 256 * g + 4 * F.lane), s4 = *(const LAS f32x4*)(sh + 256 * g + 4 * F.lane);
        const bf16* Xg = X + (size_t)b * SEQ * 1024 + 256 * g + 4 * F.lane; bf16* Dg = D + (size_t)b * SEQ * 1024 + 256 * g + 4 * F.lane;
        if (g == 0) pool_rows<2>(Xg, Dg, t0, half, rs, g4, s4); else if (g == 1) pool_rows<4>(Xg, Dg, t0, half, rs, g4, s4);
        else if (g == 2) pool_rows<8>(Xg, Dg, t0, half, rs, g4, s4); else pool_rows<16>(Xg, Dg, t0, half, rs, g4, s4);
    }
}

__device__ __forceinline__ int crow(int r, int hi) { return (r & 3) + 8 * (r >> 2) + 4 * hi; }
__device__ __forceinline__ void ph_attn(const Ctx& F, const bf16* QKV, const float* qgain, const float* kgain, const float* sinks, bf16* ATT) {
    constexpr int KS = 144, VS = 520;
    LAS unsigned char* Ks = F.lds; LAS unsigned char* Vt = F.lds + 256 * KS;
    LAS float* QR = (LAS float*)(F.lds + 256 * KS + 64 * VS);
    LAS float* GN = QR + 128 * 16;
    LAS float* KR = GN + 256;
    const float* rope = (const float*)(F.ws + WS_ROPE);
    if (F.tid < 128) GN[F.tid] = F.tid < 64 ? qgain[F.tid] : kgain[F.tid - 64];
    const int r32 = F.lane & 31, hi = F.lane >> 5;
    for (int u = F.vcu; u < 512; u += F.G) {
        const int b = u >> 8, n = (u >> 2) & 63, hk = u & 3;
        const int tok0 = b * SEQ + n * 128;
        __syncthreads();
        const int g = F.wave >> 1, qh = F.wave & 1, hq = hk * 4 + g;
        u32x4 kraw[4], vraw[4];
#pragma unroll
        for (int i = 0; i < 4; ++i) {
            const int item = F.tid + NT * i, key = item >> 3, c = item & 7;
            const int pos = n * 128 - 128 + key;
            kraw[i] = (u32x4){0u, 0u, 0u, 0u}; vraw[i] = kraw[i];
            if (pos >= 0) { const bf16* rowp = QKV + (size_t)(b * SEQ + pos) * NQKV; kraw[i] = *(const u32x4*)(rowp + 1024 + hk * 64 + 8 * c); }
            { const int vkey = item & 255, vc = item >> 8, vpos = n * 128 - 128 + vkey;
              if (vpos >= 0) vraw[i] = *(const u32x4*)(QKV + (size_t)(b * SEQ + vpos) * NQKV + 1280 + hk * 64 + 8 * vc); }
        }
        f32x4 krr[2];
#pragma unroll
        for (int i = 0; i < 2; ++i) { const int fi = F.tid * 4 + i * 2048, kp = n * 128 - 128 + (fi >> 4); krr[i] = *(const f32x4*)(rope + (size_t)(kp >= 0 ? kp : 0) * 16 + (fi & 15)); }
        const f32x4 qrr = *(const f32x4*)(rope + (size_t)(n * 128) * 16 + F.tid * 4);
        u32x4 qnext[4];
        { const bf16* qrow = QKV + (size_t)(tok0 + 64 * qh + r32) * NQKV + hq * 64;
#pragma unroll
          for (int d0 = 0; d0 < 4; ++d0) qnext[d0] = *(const u32x4*)(qrow + 16 * d0 + 8 * hi); }
#pragma unroll
        for (int i = 0; i < 2; ++i) *(LAS f32x4*)(KR + F.tid * 4 + i * 2048) = krr[i];
        *(LAS f32x4*)(QR + F.tid * 4) = qrr;
        __syncthreads();
#pragma unroll
        for (int i = 0; i < 4; ++i) {
            const int item = F.tid + NT * i, key = item >> 3, c = item & 7;
            float kf[8], pf[8];
#pragma unroll
            for (int e = 0; e < 4; ++e) { kf[2 * e] = bf_lo(kraw[i][e]); kf[2 * e + 1] = bf_hi(kraw[i][e]); }
            float ss = 0.f;
#pragma unroll
            for (int e = 0; e < 8; ++e) ss += kf[e] * kf[e];
            ss += __shfl_xor(ss, 1); ss += __shfl_xor(ss, 2); ss += __shfl_xor(ss, 4);
            const float rstd = rsqrtf(ss * (1.0f / 64.0f) + NORM_EPS);
#pragma unroll
            for (int e = 0; e < 8; ++e) kf[e] *= rstd * GN[64 + 8 * c + e];
#pragma unroll
            for (int e = 0; e < 8; ++e) pf[e] = __shfl_xor(kf[e], 1);
            if (c < 2) {
                const LAS float* rp = KR + key * 16;
#pragma unroll
                for (int e = 0; e < 8; ++e) { const float cs = rp[e], sn = rp[8 + e]; kf[e] = (c == 0) ? kf[e] * cs - pf[e] * sn : kf[e] * cs + pf[e] * sn; }
            }
            u32x4 ko; ko.x = pk2(kf[0], kf[1]); ko.y = pk2(kf[2], kf[3]); ko.z = pk2(kf[4], kf[5]); ko.w = pk2(kf[6], kf[7]);
            *(LAS u32x4*)(Ks + key * KS + c * 16) = ko;
            const int vkey = item & 255, vc = item >> 8;
#pragma unroll
            for (int e = 0; e < 4; ++e) {
                *(LAS unsigned short*)(Vt + (8 * vc + 2 * e) * VS + vkey * 2) = (unsigned short)(vraw[i][e] & 0xffffu);
                *(LAS unsigned short*)(Vt + (8 * vc + 2 * e + 1) * VS + vkey * 2) = (unsigned short)(vraw[i][e] >> 16);
            }
        }
        __syncthreads();
        const float sink2 = sinks[hq] * LOG2E;
#pragma unroll 1
        for (int qb = 0; qb < 2; ++qb) {
            const int q0 = 64 * qh + 32 * qb;
            float qf[4][8]; float ss = 0.f;
            u32x4 qcur[4];
#pragma unroll
            for (int d0 = 0; d0 < 4; ++d0) qcur[d0] = qnext[d0];
            if (qb == 0) { const bf16* qrow = QKV + (size_t)(tok0 + q0 + 32 + r32) * NQKV + hq * 64;
#pragma unroll
                for (int d0 = 0; d0 < 4; ++d0) qnext[d0] = *(const u32x4*)(qrow + 16 * d0 + 8 * hi); }
#pragma unroll
            for (int d0 = 0; d0 < 4; ++d0) { const u32x4 raw = qcur[d0];
#pragma unroll
                for (int e = 0; e < 4; ++e) { qf[d0][2 * e] = bf_lo(raw[e]); qf[d0][2 * e + 1] = bf_hi(raw[e]); } }
#pragma unroll
            for (int d0 = 0; d0 < 4; ++d0)
#pragma unroll
                for (int e = 0; e < 8; ++e) ss += qf[d0][e] * qf[d0][e];
            ss += __shfl_xor(ss, 32);
            const float rstd = rsqrtf(ss * (1.0f / 64.0f) + NORM_EPS);
#pragma unroll
            for (int d0 = 0; d0 < 4; ++d0)
#pragma unroll
                for (int e = 0; e < 8; ++e) qf[d0][e] *= rstd * GN[16 * d0 + 8 * hi + e];
            {
                const LAS float* rp = QR + (q0 + r32) * 16;
#pragma unroll
                for (int e = 0; e < 8; ++e) { const float pf = __shfl_xor(qf[0][e], 32); const float cs = rp[e], sn = rp[8 + e]; qf[0][e] = (hi == 0) ? qf[0][e] * cs - pf * sn : qf[0][e] * cs + pf * sn; }
            }
            bf16x8 qfr[4];
#pragma unroll
            for (int d0 = 0; d0 < 4; ++d0) { u32x4 w; const float sc = 0.125f * LOG2E;
                w.x = pk2(qf[d0][0] * sc, qf[d0][1] * sc); w.y = pk2(qf[d0][2] * sc, qf[d0][3] * sc); w.z = pk2(qf[d0][4] * sc, qf[d0][5] * sc); w.w = pk2(qf[d0][6] * sc, qf[d0][7] * sc);
                qfr[d0] = __builtin_bit_cast(bf16x8, w); }
            f32x16 S[5];
#pragma unroll
            for (int kb = 0; kb < 5; ++kb) {
                S[kb] = (f32x16){0.f, 0.f, 0.f, 0.f, 0.f, 0.f, 0.f, 0.f, 0.f, 0.f, 0.f, 0.f, 0.f, 0.f, 0.f, 0.f};
#pragma unroll
                for (int d0 = 0; d0 < 4; ++d0) { const bf16x8 a = *(const LAS bf16x8*)(Ks + (q0 + 32 * kb + r32) * KS + (16 * d0 + 8 * hi) * 2);
                    S[kb] = __builtin_amdgcn_mfma_f32_32x32x16_bf16(a, qfr[d0], S[kb], 0, 0, 0); }
            }
            const float NEG = -1e30f;
#pragma unroll
            for (int r = 0; r < 16; ++r) { if (crow(r, hi) <= r32) S[0][r] = NEG; if (crow(r, hi) > r32) S[4][r] = NEG; }
            if (n == 0) {
#pragma unroll
                for (int kb = 0; kb < 5; ++kb)
#pragma unroll
                    for (int r = 0; r < 16; ++r) if (q0 + 32 * kb + crow(r, hi) < 128) S[kb][r] = NEG;
            }
            float mx = sink2;
#pragma unroll
            for (int kb = 0; kb < 5; ++kb)
#pragma unroll
                for (int r = 0; r < 16; ++r) mx = fmaxf(mx, S[kb][r]);
            mx = fmaxf(mx, __shfl_xor(mx, 32));
            float sum = 0.f;
#pragma unroll
            for (int kb = 0; kb < 5; ++kb)
#pragma unroll
                for (int r = 0; r < 16; ++r) { const float p = __builtin_amdgcn_exp2f(S[kb][r] - mx); S[kb][r] = p; sum += p; }
            sum += __shfl_xor(sum, 32);
            sum += __builtin_amdgcn_exp2f(sink2 - mx);
            const float inv = 1.0f / sum;
            f32x16 O[2];
            O[0] = (f32x16){0.f, 0.f, 0.f, 0.f, 0.f, 0.f, 0.f, 0.f, 0.f, 0.f, 0.f, 0.f, 0.f, 0.f, 0.f, 0.f}; O[1] = O[0];
#pragma unroll
            for (int kb = 0; kb < 5; ++kb)
#pragma unroll
                for (int hf = 0; hf < 2; ++hf) {
                    u32x4 pw; pw.x = pk2(S[kb][8 * hf + 0], S[kb][8 * hf + 1]); pw.y = pk2(S[kb][8 * hf + 2], S[kb][8 * hf + 3]); pw.z = pk2(S[kb][8 * hf + 4], S[kb][8 * hf + 5]); pw.w = pk2(S[kb][8 * hf + 6], S[kb][8 * hf + 7]);
                    const bf16x8 pfrag = __builtin_bit_cast(bf16x8, pw);
                    const int base = q0 + 32 * kb + 16 * hf;
#pragma unroll
                    for (int db = 0; db < 2; ++db) {
                        const u32x2 lo = *(const LAS u32x2*)(Vt + (32 * db + r32) * VS + (base + 4 * hi) * 2), hi2 = *(const LAS u32x2*)(Vt + (32 * db + r32) * VS + (base + 8 + 4 * hi) * 2);
                        u32x4 vw; vw.x = lo.x; vw.y = lo.y; vw.z = hi2.x; vw.w = hi2.y;
                        O[db] = __builtin_amdgcn_mfma_f32_32x32x16_bf16(__builtin_bit_cast(bf16x8, vw), pfrag, O[db], 0, 0, 0);
                    }
                }
            bf16* orow = ATT + (size_t)(tok0 + q0 + r32) * 1024 + hq * 64;
#pragma unroll
            for (int db = 0; db < 2; ++db)
#pragma unroll
                for (int rg = 0; rg < 4; ++rg) { u32x2 w; w.x = pk2(O[db][4 * rg] * inv, O[db][4 * rg + 1] * inv); w.y = pk2(O[db][4 * rg + 2] * inv, O[db][4 * rg + 3] * inv);
                    *(u32x2*)(orow + 32 * db + 8 * rg + 4 * hi) = w; }
        }
    }
}

__device__ __forceinline__ void cvec_job(const Ctx& F, int l) {
    const float* MODF = (const float*)(F.ws + WS_MODF); float* CV = (float*)(F.ws + WS_CVEC);
    const int gw = F.vcu * NWAVES + F.wave, NGW = F.G * NWAVES;
    for (int r = gw; r < NUP; r += NGW) {
        const bf16* wrow = (const bf16*)(F.ws + WS_WUP) + ((size_t)l * NUP + r) * 1024;
        float d0 = 0.f, d1 = 0.f;
#pragma unroll
        for (int h = 0; h < 2; ++h) { const int k0 = h * 512 + F.lane * 8; const u32x4 w = *(const u32x4*)(wrow + k0);
            const float* s0 = MODF + (size_t)(l * 2 + 0) * 6144 + 3 * 1024 + k0; const float* s1 = MODF + (size_t)(l * 2 + 1) * 6144 + 3 * 1024 + k0;
#pragma unroll
            for (int e = 0; e < 4; ++e) { const float wl = bf_lo(w[e]), wh = bf_hi(w[e]); d0 += wl * s0[2 * e] + wh * s0[2 * e + 1]; d1 += wl * s1[2 * e] + wh * s1[2 * e + 1]; } }
        d0 = wave_sum(d0); d1 = wave_sum(d1);
        if (F.lane == 0) { CV[(size_t)(l * 2 + 0) * NUP + r] = d0; CV[(size_t)(l * 2 + 1) * NUP + r] = d1; }
    }
}

__device__ __forceinline__ void fixup_tile(const Ctx& F, const float* cw, bf16* ACT, int pm) {
    if ((pm & 31) == 0) return;
    const float* HALO = (const float*)(F.ws + WS_HALO); const float* PART = (const float*)(F.ws + WS_PART);
    static_assert(2 * DFF == 11 * NT, "fixup_tile: 11 outputs per thread");
#pragma unroll
    for (int it = 0; it < 11; ++it) {
        const int idx = F.tid + it * NT;
        const int fr = idx / DFF, j = idx % DFF;
        const float* hb = HALO + (size_t)((pm - 1) * 2) * NUP; const float* pb = PART + (size_t)(pm * 2 + fr) * NUP;
        float g = pb[j], v = pb[DFF + j];
        const float h0g = hb[j], h1g = hb[NUP + j], h0v = hb[DFF + j], h1v = hb[NUP + DFF + j];
        if (fr == 0) { g += cw[NUP + j] * h1g + cw[j] * h0g; v += cw[NUP + DFF + j] * h1v + cw[DFF + j] * h0v; }
        else { g += cw[j] * h1g; v += cw[DFF + j] * h1v; }
        const float a = pg8::silu_f(g) * v;
        ACT[(size_t)(pm * 256 + fr) * DFF + j] = (bf16)(pk2(a, a) & 0xffffu);
    }
}

struct Args { const float* in[17]; float* out; unsigned char* ws; int ph_lo, ph_hi, use_cg, pad; };
constexpr int NPHASE = 11;

__global__ void __launch_bounds__(NT, 2) fwd_kernel(Args args) {
    extern __shared__ __attribute__((aligned(16))) unsigned char lds_raw[];
    Ctx F;
    F.lds = (LAS unsigned char*)lds_raw; F.tid = threadIdx.x; F.lane = F.tid & 63; F.wave = __builtin_amdgcn_readfirstlane(F.tid >> 6);
    F.G = gridDim.x; { const int bx = blockIdx.x; F.vcu = (F.G % 8 == 0) ? (bx % 8) * (F.G / 8) + bx / 8 : bx; }
    F.ws = args.ws;
    unsigned icw = 0u;
    { const unsigned long long pc = ((unsigned long long)__builtin_amdgcn_s_getpc()) & ~15ull;
      if (F.tid < 360) { const u32x4 cv = *(const volatile u32x4*)(pc + (unsigned long long)(((int)blockIdx.x >> 3) & 31) * 5760ull + (unsigned long long)F.tid * 16ull); icw = cv.x ^ cv.y ^ cv.z ^ cv.w; } }
    volatile LAS unsigned* MISC = (volatile LAS unsigned*)(F.lds + MISC_OFF);
    if (F.tid < 16) MISC[F.tid] = 0u;
    __syncthreads();
    XcdBarrier bar = xcd_barrier_post((unsigned*)(F.ws + WS_CTL) + CW_BAR, MISC + 8);
    const int lo = args.ph_lo, hi = args.ph_hi;
#ifndef PHASE_MASK
#define PHASE_MASK 0x7ff
#endif
#define IN(k) (((PHASE_MASK >> (k)) & 1) && lo <= (k) && (k) < hi)
#ifndef DUP_BAR
#define DUP_BAR 0
#endif
#ifndef DUP_MASK
#define DUP_MASK 0
#endif
#define REP(k) for (int rep_ = 0; rep_ < 1 + ((DUP_MASK >> (k)) & 1); ++rep_)
#define SEAM(k) do { if (IN(k) && IN((k) + 1)) { if (args.use_cg) cg::this_grid().sync(); else { xcd_barrier(bar); if (DUP_BAR) xcd_barrier(bar); } } } while (0)
    const float* const* in = args.in;
      bf16* X = (bf16*)(F.ws + WS_X); bf16* H = (bf16*)(F.ws + WS_H); bf16* QKV = (bf16*)(F.ws + WS_QKV); bf16* ATT = (bf16*)(F.ws + WS_ATT); bf16* ACT = (bf16*)(F.ws + WS_ACT);
    const float* MODF = (const float*)(F.ws + WS_MODF);
    LAS unsigned char* xl = F.lds + XL_OFF;

    float* SS = (float*)(F.ws + WS_SS); const float* GM = (const float*)(F.ws + WS_GM); const float* CV = (const float*)(F.ws + WS_CVEC);
    if (IN(0)) REP(0) ph_prologue(F, in);
    if (icw == 0x9E3779B9u && args.use_cg) ((unsigned*)(F.ws + WS_CTL + 61440))[F.tid] = icw;
    SEAM(0);
    if (IN(1)) REP(1) ph_norm<true>(F, in[0], in[4], in[3], 0, 0, H, in[5]);
    SEAM(1);
    if (IN(2)) { pg8::Gemm g{H, (const bf16*)(F.ws + WS_WQKV), 1024, 1024, 1024, 0}; pg8::StaticOrder S; S.init(M, NQKV, F.G, (int)blockIdx.x);
        pg8::EpiBf16 E{QKV, NQKV}; pg8::gemm_phase<pg8::EpiBf16, pg8::StaticOrder, true, true>(F.lds, g, S, E);
        if ((DUP_MASK >> 2) & 1) { __syncthreads(); pg8::gemm_phase<pg8::EpiBf16, pg8::StaticOrder, true, true>(F.lds, g, S, E); }
        { const int nwg = (M / 256) * (NQKV / 256), rounds = (nwg + F.G - 1) / F.G, nidle = rounds * F.G - nwg, c = (int)blockIdx.x;
          __syncthreads();
          if (nidle == 0) convert_rest(F, in, c, F.G, 0); else if (c >= F.G - nidle) convert_rest(F, in, c - (F.G - nidle), nidle, 0); } }
    SEAM(2);
    if (IN(3)) { REP(3) ph_attn(F, QKV, in[7], in[8], in[9], ATT); cvec_job(F, 0); }
    SEAM(3);
    if (IN(4)) { pg8::Gemm g{ATT, (const bf16*)(F.ws + WS_WO), 1024, 1024, 1024, 0}; pg8::StaticOrder S; S.init(M, 1024, F.G, (int)blockIdx.x);
        pg8::EpiRes<true, true, false, true> E{in[0], X, MODF + 0 * 12288 + 2 * 1024, nullptr, H, GM, SS}; pg8::gemm_phase<pg8::EpiRes<true, true, false, true>, pg8::StaticOrder, true, true>(F.lds, g, S, E); }
    SEAM(4);
#define UP(l, ph) do { if (IN(ph)) { pg8::Gemm g{H, (const bf16*)(F.ws + WS_WUP) + (size_t)(l) * NUP * 1024, 1024, 1024, 1024, 0}; pg8::StaticOrder S; S.init(M, NUP, F.G, (int)blockIdx.x); \
            pg8::EpiUp E{ACT, in[14] + (size_t)(l) * 3 * NUP, in[15] + (size_t)(l) * NUP, (float*)(F.ws + WS_HALO), (float*)(F.ws + WS_PART), xl, SS + (size_t)(2 * (l)) * M, CV + (size_t)(l) * 2 * NUP}; \
            pg8::gemm_phase<pg8::EpiUp, pg8::StaticOrder, true, true>(F.lds, g, S, E); \
            if ((l) == 0) { const int nwg = (M / 256) * (NUP / 256), rounds = (nwg + F.G - 1) / F.G, nidle = rounds * F.G - nwg, c = (int)blockIdx.x; __syncthreads(); \
                if (nidle == 0) convert_rest(F, in, c, F.G, 1); else if (c >= F.G - nidle) convert_rest(F, in, c - (F.G - nidle), nidle, 1); } } } while (0)
#define DOWN_PRE(l) pg8::Gemm g{ACT, (const bf16*)(F.ws + WS_WDN) + (size_t)(l) * 1024 * DFF, DFF, DFF, DFF, 0}; pg8::StaticOrder S; S.init(M, 1024, F.G, (int)blockIdx.x); \
            { pg8::Unit fu; for (int fi = 0; S.next(fi, fu); ++fi) fixup_tile(F, in[14] + (size_t)(l) * 3 * NUP, ACT, fu.pm); asm volatile("s_waitcnt vmcnt(0)" ::: "memory"); __syncthreads(); }
    UP(0, 5);
    SEAM(5);
    if (IN(6)) { DOWN_PRE(0)
        pg8::EpiRes<false, true, true, true> E{X, X, MODF + 0 * 12288 + 5 * 1024, nullptr, nullptr, nullptr, SS + M}; pg8::gemm_phase<pg8::EpiRes<false, true, true, true>, pg8::StaticOrder, true, true>(F.lds, g, S, E); }
    SEAM(6);
    if (IN(7)) { REP(7) ph_pooldiff(F, X, in[4] + 1024, 1, ATT, SS + M); cvec_job(F, 1); }
    SEAM(7);
    if (IN(8)) { pg8::Gemm g{ATT, (const bf16*)(F.ws + WS_WPOOL), 1024, 256, 256, 256}; pg8::StaticOrder S; S.init(M, 1024, F.G, (int)blockIdx.x);
        pg8::EpiRes<true, true, true, true> E{X, X, MODF + 1 * 12288 + 2 * 1024, in[12], H, GM + 2048, SS + 2 * M}; pg8::gemm_phase<pg8::EpiRes<true, true, true, true>, pg8::StaticOrder, true, true>(F.lds, g, S, E); }
    SEAM(8);
    UP(1, 9);
    SEAM(9);
    if (IN(10)) { DOWN_PRE(1)
        pg8::EpiRes<false, false, true, false> E{X, args.out, MODF + 1 * 12288 + 5 * 1024, nullptr, nullptr, nullptr, nullptr}; pg8::gemm_phase<pg8::EpiRes<false, false, true, false>, pg8::StaticOrder, true, true>(F.lds, g, S, E); }
#undef UP
#undef DOWN_PRE
#undef IN
#undef SEAM
}

extern "C" void kernel_launch(void* const* d_in, const int* in_sizes, int n_in, void* d_out, int out_size, void* d_ws, size_t ws_size, hipStream_t stream) {
    static int grid = 0;
    if (grid == 0) {
        if (n_in != 17 || out_size != M * DM || ws_size < WS_END) { fprintf(stderr, "kernel_launch: unexpected shapes (n_in %d out %d ws %zu)\n", n_in, out_size, ws_size); grid = -1; return; }
        int dev = 0, cus = 0, per_cu = 0;
        if (hipGetDevice(&dev) != hipSuccess || hipDeviceGetAttribute(&cus, hipDeviceAttributeMultiprocessorCount, dev) != hipSuccess) { grid = -1; return; }
        if (hipFuncSetAttribute((const void*)fwd_kernel, hipFuncAttributeMaxDynamicSharedMemorySize, LDS_BYTES) != hipSuccess) { fprintf(stderr, "kernel_launch: hipFuncSetAttribute failed\n"); grid = -1; return; }
        if (hipOccupancyMaxActiveBlocksPerMultiprocessor(&per_cu, (const void*)fwd_kernel, NT, LDS_BYTES) != hipSuccess || per_cu < 1) { fprintf(stderr, "kernel_launch: occupancy query says %d\n", per_cu); per_cu = 1; }
        (void)hipGetLastError();
        grid = cus * 1;
    }
    if (grid < 0) return;
    (void)hipMemsetAsync((char*)d_ws + WS_CTL, 0, CTL_ZERO_BYTES, stream);
    Args a{};
    for (int i = 0; i < 17; ++i) a.in[i] = (const float*)d_in[i];
    a.out = (float*)d_out; a.ws = (unsigned char*)d_ws; a.ph_lo = 0; a.ph_hi = NPHASE; a.use_cg = 0; a.pad = 0;
    void* kargs[] = {&a};
    hipError_t e = hipLaunchCooperativeKernel((const void*)fwd_kernel, dim3(grid), dim3(NT), kargs, LDS_BYTES, stream);
    if (e != hipSuccess) fprintf(stderr, "kernel_launch: cooperative launch failed: %s (grid %d)\n", hipGetErrorString(e), grid);
}
```

```cpp
#include <hip/hip_runtime.h>
#include <hip/hip_cooperative_groups.h>
#include <cstdio>
#include <cstdint>
namespace cg = cooperative_groups;

namespace pg8 {
#define PG8_LAS __attribute__((address_space(3)))
typedef unsigned short bf16_t;
typedef short bf16x8 __attribute__((ext_vector_type(8)));
typedef float f32x4 __attribute__((ext_vector_type(4)));
typedef unsigned u32x4 __attribute__((ext_vector_type(4)));
constexpr int BM = 256, BK = 64, HALF = 128, HTB = HALF * BK * 2  , STAGE_BYTES = 8 * HTB, NXCD = 8, WGM = 8;

__host__ __device__ __forceinline__ int lds_byte(int r, int c) { const int st = (r >> 4) * 2 + (c >> 5), rr = r & 15, cc = c & 31, ob = rr * 64 + cc * 2; return st * 1024 + (ob ^ (((ob >> 9) & 1) << 5)); }
__host__ __device__ __forceinline__ void stage_rc(int b, int& R, int& C) { const int st = b / 1024, sb = b % 1024, swz = sb ^ (((sb >> 9) & 1) << 5); R = (st >> 1) * 16 + swz / 64; C = (st & 1) * 32 + (swz % 64) / 2; }
__host__ __device__ __forceinline__ int perm32(int rho) { const int n = rho >> 4, i = rho & 15; return 8 * (i >> 2) + 4 * n + (i & 3); }

struct Unit { int pm, pn; };
struct Gemm { const bf16_t* A; const bf16_t* Bt; int lda, ldb, K, a_pn_off; };

struct StaticOrder {
    int nM, nN, nwg, G, c;
    __host__ __device__ void init(int M, int N, int G_, int c_) { nM = M / BM; nN = N / BM; nwg = nM * nN; G = G_; c = c_; }
    __host__ __device__ __forceinline__ bool next(int i, Unit& u) const {
        const long L = (long)i * G + c; if (L >= nwg) return false;
        int wgid = (int)L; { const int q = nwg / NXCD, r = nwg % NXCD, xcd = wgid % NXCD, off = wgid / NXCD; wgid = (xcd < r ? xcd * (q + 1) : r * (q + 1) + (xcd - r) * q) + off; }
        const int nig = WGM * nN, gid = wgid / nig, fm = gid * WGM, gsz = (nM - fm) < WGM ? (nM - fm) : WGM;
        u.pm = fm + ((wgid % nig) % gsz); u.pn = (wgid % nig) / gsz; return true;
    }
    __device__ __forceinline__ void a_ready(const Unit&) const {}
    __device__ __forceinline__ void done(const Unit&) const {}
};

__device__ __forceinline__ unsigned cvt_pk_bf16(float lo, float hi) { unsigned r; asm volatile("v_cvt_pk_bf16_f32 %0, %1, %2" : "=v"(r) : "v"(lo), "v"(hi)); return r; }
template <int CTRL> __device__ __forceinline__ float dppf(float v) { return __builtin_bit_cast(float, __builtin_amdgcn_update_dpp(0, __builtin_bit_cast(int, v), CTRL, 0xf, 0xf, true)); }
__device__ __forceinline__ float silu_f(float g) { return g * __builtin_amdgcn_rcpf(1.0f + __builtin_amdgcn_exp2f(-1.4426950408889634f * g)); }


struct EpiBf16 {
    static constexpr bool PERM = true, AFTER_DRAIN = false;
    bf16_t* O; int ldc;
    __device__ __forceinline__ void prefetch(const Unit&, int, int, int) const {}
    __device__ __forceinline__ void operator()(f32x4 (&acc)[2][2][4][2], const Unit& u, int wr, int wc, int fr, int fq, int wid, int lane, int ui) const {
        const int row0 = u.pm * BM + wr * 64 + fr, col0 = u.pn * BM + wc * 32 + 8 * fq;
#pragma unroll
        for (int ai = 0; ai < 2; ++ai)
#pragma unroll
            for (int m = 0; m < 4; ++m) { bf16_t* rowp = O + (size_t)(row0 + ai * HALF + m * 16) * ldc + col0;
#pragma unroll
                for (int bj = 0; bj < 2; ++bj) { const f32x4 v0 = acc[ai][bj][m][0], v1 = acc[ai][bj][m][1];
                    u32x4 w; w.x = cvt_pk_bf16(v0[0], v0[1]); w.y = cvt_pk_bf16(v0[2], v0[3]); w.z = cvt_pk_bf16(v1[0], v1[1]); w.w = cvt_pk_bf16(v1[2], v1[3]);
                    *(u32x4*)(rowp + bj * HALF) = w; } }
    }
};

template <bool WA, bool WS, bool BB  , bool OB  >
struct EpiRes {
    static constexpr bool PERM = true, AFTER_DRAIN = false, NTB = !BB || !OB;
    const void* base; void* out; const float* gate  ; const float* cscale  ;
    bf16_t* An; const float* gmul  ; float* ss  ;
    __device__ __forceinline__ void prefetch(const Unit&, int, int, int) const {}
    __device__ __forceinline__ void operator()(f32x4 (&acc)[2][2][4][2], const Unit& u, int wr, int wc, int fr, int fq, int wid, int lane, int ui) const {
        const int col0 = u.pn * BM + wc * 32 + 8 * fq; const int b = u.pm >> 5;
        f32x4 gv[2][2];
#pragma unroll
        for (int bj = 0; bj < 2; ++bj)
#pragma unroll
            for (int n = 0; n < 2; ++n) { const int c = col0 + bj * HALF + n * 4; f32x4 g = *(const f32x4*)(gate + (size_t)b * 6144 + c); if (cscale) g = g * *(const f32x4*)(cscale + c); gv[bj][n] = g; }
        constexpr int NB = (WA && BB) ? 1 : 2;
#pragma unroll
        for (int hq_ = 0; hq_ < 8 / NB; ++hq_) {
            const int ai = (hq_ * NB) >> 2, m0 = (hq_ * NB) & 3;
            const int rowb = u.pm * BM + ai * HALF + wr * 64 + fr;
            f32x4 pre[NB][2][2]; u32x4 preb[NB][2];
#pragma unroll
            for (int mm = 0; mm < NB; ++mm)
#pragma unroll
                for (int bj = 0; bj < 2; ++bj) {
                    const size_t o_ = (size_t)(rowb + (m0 + mm) * 16) * 1024 + col0 + bj * HALF;
                    if (BB) preb[mm][bj] = NTB ? __builtin_nontemporal_load((const u32x4*)((const bf16_t*)base + o_)) : *(const u32x4*)((const bf16_t*)base + o_);
                    else { pre[mm][bj][0] = NTB ? __builtin_nontemporal_load((const f32x4*)((const float*)base + o_)) : *(const f32x4*)((const float*)base + o_);
                           pre[mm][bj][1] = NTB ? __builtin_nontemporal_load((const f32x4*)((const float*)base + o_ + 4)) : *(const f32x4*)((const float*)base + o_ + 4); } }
            asm volatile("" ::: "memory");
            float sq[NB];
#pragma unroll
            for (int mm = 0; mm < NB; ++mm) { sq[mm] = 0.f;
#pragma unroll
                for (int bj = 0; bj < 2; ++bj) {
                    if (BB) { const u32x4 w = preb[mm][bj];
                        pre[mm][bj][0] = (f32x4){__uint_as_float(w.x << 16), __uint_as_float(w.x & 0xffff0000u), __uint_as_float(w.y << 16), __uint_as_float(w.y & 0xffff0000u)};
                        pre[mm][bj][1] = (f32x4){__uint_as_float(w.z << 16), __uint_as_float(w.z & 0xffff0000u), __uint_as_float(w.w << 16), __uint_as_float(w.w & 0xffff0000u)}; }
#pragma unroll
                    for (int n = 0; n < 2; ++n) { const f32x4 o = pre[mm][bj][n] + gv[bj][n] * acc[ai][bj][m0 + mm][n]; acc[ai][bj][m0 + mm][n] = o;
                        if (WS) sq[mm] += (o[0] * o[0] + o[1] * o[1]) + (o[2] * o[2] + o[3] * o[3]); } } }
            asm volatile("" ::: "memory");
#pragma unroll
            for (int mm = 0; mm < NB; ++mm) { const int m = m0 + mm; const size_t off = (size_t)(rowb + m * 16) * 1024 + col0;
#pragma unroll
                for (int bj = 0; bj < 2; ++bj) {
                    if (OB) { const f32x4 a0 = acc[ai][bj][m][0], a1 = acc[ai][bj][m][1]; u32x4 w; w.x = cvt_pk_bf16(a0[0], a0[1]); w.y = cvt_pk_bf16(a0[2], a0[3]); w.z = cvt_pk_bf16(a1[0], a1[1]); w.w = cvt_pk_bf16(a1[2], a1[3]);
                        *(u32x4*)((bf16_t*)out + off + bj * HALF) = w; }
                    else {
#pragma unroll
                        for (int n = 0; n < 2; ++n) __builtin_nontemporal_store(acc[ai][bj][m][n], (f32x4*)((float*)out + off + bj * HALF + n * 4)); }
                }
                if (WS) { float q = sq[mm]; q += __shfl_xor(q, 16); q += __shfl_xor(q, 32); if (fq == 0) atomicAdd(ss + rowb + m * 16, q); } }
            asm volatile("" ::: "memory");
        }
        if (WA) {
            f32x4 gm[2][2];
#pragma unroll
            for (int bj = 0; bj < 2; ++bj)
#pragma unroll
                for (int n = 0; n < 2; ++n) gm[bj][n] = *(const f32x4*)(gmul + (size_t)b * 1024 + col0 + bj * HALF + n * 4);
#pragma unroll
            for (int ai = 0; ai < 2; ++ai)
#pragma unroll
                for (int m = 0; m < 4; ++m) { const size_t off = (size_t)(u.pm * BM + ai * HALF + wr * 64 + fr + m * 16) * 1024 + col0;
#pragma unroll
                    for (int bj = 0; bj < 2; ++bj) { const f32x4 a0 = acc[ai][bj][m][0] * gm[bj][0], a1 = acc[ai][bj][m][1] * gm[bj][1]; u32x4 w; w.x = cvt_pk_bf16(a0[0], a0[1]); w.y = cvt_pk_bf16(a0[2], a0[3]); w.z = cvt_pk_bf16(a1[0], a1[1]); w.w = cvt_pk_bf16(a1[2], a1[3]);
                        *(u32x4*)(An + off + bj * HALF) = w; } }
        }
    }
};

struct EpiUp {
    static constexpr bool PERM = true, AFTER_DRAIN = false;
    bf16_t* act; const float* cw  ; const float* cb  ; float* halo; float* part; PG8_LAS unsigned char* xl  ;
    const float* ss  ; const float* cvec  ;
    __device__ __forceinline__ void prefetch(const Unit& u, int ui, int wid, int lane) const {
        PG8_LAS float* wl = (PG8_LAS float*)(xl + 8192 + 256) + (ui & 1) * 1536;
        const int t = wid * 64 + lane, c = t & 255, hi_ = t >> 8;
        const int gcol = (c >> 7) * 2816 + u.pn * HALF + (c & 127);
        const float* s0 = cw + (size_t)hi_ * 5632 + gcol;
        const float* s1 = hi_ == 0 ? cw + 2 * 5632 + gcol : cb + gcol;
        const float* s2 = hi_ == 0 ? ss + u.pm * BM + c : cvec + (size_t)(u.pm >> 5) * 5632 + u.pn * BM + c;
        __builtin_amdgcn_global_load_lds((const unsigned*)s0, (PG8_LAS unsigned*)(wl + wid * 64), 4, 0, 0);
        __builtin_amdgcn_global_load_lds((const unsigned*)s1, (PG8_LAS unsigned*)(wl + 512 + wid * 64), 4, 0, 0);
        __builtin_amdgcn_global_load_lds((const unsigned*)s2, (PG8_LAS unsigned*)(wl + 1024 + wid * 64), 4, 0, 0);
    }
    __device__ __forceinline__ void operator()(f32x4 (&acc)[2][2][4][2], const Unit& u, int wr, int wc, int fr, int fq, int wid, int lane, int ui) const {
        const int cbase = wc * 32 + 8 * fq;
        PG8_LAS float* wl = (PG8_LAS float*)(xl + 8192 + 256) + (ui & 1) * 1536;
        asm volatile("" ::: "memory");
        {
            f32x4 cv[2][2];
#pragma unroll
            for (int bj = 0; bj < 2; ++bj)
#pragma unroll
                for (int n = 0; n < 2; ++n) cv[bj][n] = *(const PG8_LAS f32x4*)(wl + 5 * 256 + bj * HALF + cbase + 4 * n);
#pragma unroll
            for (int ai = 0; ai < 2; ++ai)
#pragma unroll
                for (int m = 0; m < 4; ++m) { const float rs = __builtin_amdgcn_rsqf(wl[4 * 256 + ai * HALF + wr * 64 + m * 16 + fr] * (1.0f / 1024.0f) + 1e-6f);
#pragma unroll
                    for (int bj = 0; bj < 2; ++bj)
#pragma unroll
                        for (int n = 0; n < 2; ++n) acc[ai][bj][m][n] = acc[ai][bj][m][n] * rs + cv[bj][n]; }
        }
        if (fr >= 14) {
#pragma unroll
            for (int ai = 0; ai < 2; ++ai)
#pragma unroll
                for (int bj = 0; bj < 2; ++bj)
#pragma unroll
                    for (int n = 0; n < 2; ++n) *(PG8_LAS f32x4*)(xl + ((((ai * 2 + wr) * 2 + (fr - 14)) * 256) + bj * HALF + cbase + 4 * n) * 4) = acc[ai][bj][3][n];
            if (wr == 1) {
#pragma unroll
                for (int bj = 0; bj < 2; ++bj)
#pragma unroll
                    for (int n = 0; n < 2; ++n) *(f32x4*)(halo + ((size_t)(u.pm * 2 + (fr - 14)) * 5632 + bj * 2816 + u.pn * HALF + cbase + 4 * n)) = acc[1][bj][3][n];
            }
        }
        asm volatile("s_waitcnt lgkmcnt(0)" ::: "memory"); __builtin_amdgcn_s_barrier(); asm volatile("" ::: "memory");
#pragma unroll
        for (int n = 0; n < 2; ++n) {
            const int j0 = u.pn * HALF + cbase + 4 * n;
#pragma unroll
            for (int ai = 0; ai < 2; ++ai) {
                const int blk = ai * 2 + wr;
                const bool first = (blk == 0 && fr < 2);
#pragma unroll
                for (int bj = 1; bj >= 0; --bj) {
                    const PG8_LAS float* wp = wl + bj * HALF + cbase + 4 * n;
                    const f32x4 w0 = *(const PG8_LAS f32x4*)(wp), w1 = *(const PG8_LAS f32x4*)(wp + 256), w2 = *(const PG8_LAS f32x4*)(wp + 512), bb = *(const PG8_LAS f32x4*)(wp + 768);
                    f32x4 V = (f32x4){0.f, 0.f, 0.f, 0.f};
                    if (blk > 0 && fr >= 14) V = *(const PG8_LAS f32x4*)(xl + ((((blk - 1) * 2 + (fr - 14)) * 256) + bj * HALF + cbase + 4 * n) * 4);
                    asm volatile("s_nop 4" ::: "memory");
#pragma unroll
                    for (int m = 3; m >= 0; --m) {
                        const f32x4 cur = acc[ai][bj][m][n];
                        const f32x4 prv = m > 0 ? acc[ai][bj][m > 0 ? m - 1 : 0][n] : V;
                        f32x4 res; const f32x4 r4 = bb + w2 * cur;
#pragma unroll
                        for (int e = 0; e < 4; ++e) {
                            float r = r4[e];
                            const float c_ = cur[e], p_ = prv[e], w1_ = w1[e], w0_ = w0[e];
                            asm volatile("v_fmac_f32_dpp %0, %1, %2 row_shr:1 row_mask:0xf bank_mask:0xf" : "+v"(r) : "v"(c_), "v"(w1_));
                            asm volatile("v_fmac_f32_dpp %0, %1, %2 row_shr:2 row_mask:0xf bank_mask:0xf" : "+v"(r) : "v"(c_), "v"(w0_));
                            asm volatile("v_fmac_f32_dpp %0, %1, %2 row_shl:15 row_mask:0xf bank_mask:0xf" : "+v"(r) : "v"(p_), "v"(w1_));
                            asm volatile("v_fmac_f32_dpp %0, %1, %2 row_shl:14 row_mask:0xf bank_mask:0xf" : "+v"(r) : "v"(p_), "v"(w0_));
                            res[e] = r;
                        }
                        if (m == 0 && first) *(f32x4*)(part + (size_t)(u.pm * 2 + fr) * 5632 + bj * 2816 + j0) = res;
                        if (bj == 0) {
                            const f32x4 vv = acc[ai][1][m][n];
                            const f32x4 ng = res * (-1.4426950408889634f); f32x4 ex;
#pragma unroll
                            for (int e = 0; e < 4; ++e) ex[e] = __builtin_amdgcn_exp2f(ng[e]);
                            const f32x4 dn = ex + 1.0f; f32x4 rc;
#pragma unroll
                            for (int e = 0; e < 4; ++e) rc[e] = __builtin_amdgcn_rcpf(dn[e]);
                            res = (res * vv) * rc;
                        }
                        acc[ai][bj][m][n] = res;
                        asm volatile("" : "+v"(acc[ai][bj][m][n]));
                    }
                }
            }
        }
        const int row0 = u.pm * BM + wr * 64 + fr;
#pragma unroll
        for (int ai = 0; ai < 2; ++ai)
#pragma unroll
            for (int m = 0; m < 4; ++m) { const f32x4 v0 = acc[ai][0][m][0], v1 = acc[ai][0][m][1];
                u32x4 w; w.x = cvt_pk_bf16(v0[0], v0[1]); w.y = cvt_pk_bf16(v0[2], v0[3]); w.z = cvt_pk_bf16(v1[0], v1[1]); w.w = cvt_pk_bf16(v1[2], v1[3]);
                *(u32x4*)(act + (size_t)(row0 + ai * HALF + m * 16) * 2816 + u.pn * HALF + cbase) = w; }
    }
};

template <class Epi, class Sched, bool ALIGN_EPI = false, bool SP2 = false>
__device__ __forceinline__ void gemm_phase(PG8_LAS unsigned char* lds, const Gemm g, const Sched& S, const Epi& E) {
    const int tid = threadIdx.x, wid = __builtin_amdgcn_readfirstlane(tid >> 6), lane = tid & 63, wr = wid >> 2, wc = wid & 3, fr = lane & 15, fq = lane >> 4;
    const int K = g.K, nt = K / BK;
    unsigned voffA[2], voffB[2];
#pragma unroll
    for (int i = 0; i < 2; ++i) { int R, C; stage_rc(tid * 16 + i * 8192, R, C); const int Rb = Epi::PERM ? ((R & ~31) + perm32(R & 31)) : R;
        voffA[i] = (unsigned)(R * g.lda + C) * 2u; voffB[i] = (unsigned)(Rb * g.ldb + C) * 2u; }
    const size_t kstep = (size_t)(BK * 2);
    const size_t hsA = (size_t)HALF * g.lda * 2, hsB = (size_t)HALF * g.ldb * 2;
    const size_t tsA = 2 * hsA, tsB = 2 * hsB, pnA = (size_t)g.a_pn_off * 2;
    const unsigned ldsw = (unsigned)wid * 1024u;
    const int aoff = lds_byte(wr * 64 + fr, fq * 8), boff = lds_byte(wc * 32 + fr, fq * 8);
#define PG8_SA(b, h) (((b) * 2 + (h)) * HTB)
#define PG8_SB(b, h) ((4 + (b) * 2 + (h)) * HTB)
#define PG8_STAGE(bufoff, gbase, voff) do { _Pragma("unroll") for (int _i = 0; _i < 2; ++_i) \
        __builtin_amdgcn_global_load_lds((const unsigned*)((const char*)(gbase) + (voff)[_i]), (PG8_LAS unsigned*)(lds + (bufoff) + ldsw + _i * 8192), 16, 0, 0); } while (0)
#define PG8_LDA(dst, b, h) do { _Pragma("unroll") for (int m = 0; m < 4; ++m) _Pragma("unroll") for (int k = 0; k < 2; ++k) dst[m][k] = *(const PG8_LAS bf16x8*)(lds + PG8_SA(b, h) + aoff + m * 2048 + k * 1024); } while (0)
#define PG8_LDB(dst, b, h) do { _Pragma("unroll") for (int n = 0; n < 2; ++n) _Pragma("unroll") for (int k = 0; k < 2; ++k) dst[n][k] = *(const PG8_LAS bf16x8*)(lds + PG8_SB(b, h) + boff + n * 2048 + k * 1024); } while (0)
#define PG8_MMA(ai, bj, At, Bt) do { __builtin_amdgcn_s_setprio(1); _Pragma("unroll") for (int m = 0; m < 4; ++m) _Pragma("unroll") for (int n = 0; n < 2; ++n) _Pragma("unroll") for (int k = 0; k < 2; ++k) \
        acc[ai][bj][m][n] = __builtin_amdgcn_mfma_f32_16x16x32_bf16(Bt[n][k], At[m][k], acc[ai][bj][m][n], 0, 0, 0); __builtin_amdgcn_s_setprio(0); } while (0)
#define PG8_WAIT_V(n) asm volatile("s_waitcnt vmcnt(" #n ")" ::: "memory")
#define PG8_WAIT_L(n) asm volatile("s_waitcnt lgkmcnt(" #n ")" ::: "memory")
#define PG8_BAR __builtin_amdgcn_s_barrier()
#define PG8_SCHED __builtin_amdgcn_sched_barrier(0)
    Unit cur, nxt; int ui = 0;
    if (!S.next(0, cur)) return;
    f32x4 acc[2][2][4][2];
#pragma unroll
    for (int a = 0; a < 2; ++a)
#pragma unroll
        for (int b = 0; b < 2; ++b)
#pragma unroll
            for (int m = 0; m < 4; ++m)
#pragma unroll
                for (int n = 0; n < 2; ++n) acc[a][b][m][n] = (f32x4){0.f, 0.f, 0.f, 0.f};
    bf16x8 At[4][2], B0[2][2], B1[2][2];
    const char* cA = (const char*)g.A + (size_t)cur.pm * tsA + (size_t)cur.pn * pnA; const char* cB = (const char*)g.Bt + (size_t)cur.pn * tsB;
    S.a_ready(cur);
    E.prefetch(cur, 0, wid, lane);
    if constexpr (SP2) {
        PG8_STAGE(PG8_SB(0, 0), cB, voffB); PG8_STAGE(PG8_SB(0, 1), cB + hsB, voffB); PG8_STAGE(PG8_SA(0, 0), cA, voffA); PG8_STAGE(PG8_SA(0, 1), cA + hsA, voffA);
        if (wr == 1) PG8_BAR;
        PG8_WAIT_V(2); PG8_BAR;
        PG8_STAGE(PG8_SB(1, 0), cB + kstep, voffB); PG8_STAGE(PG8_SA(1, 0), cA + kstep, voffA); PG8_STAGE(PG8_SB(1, 1), cB + hsB + kstep, voffB);
        PG8_WAIT_V(6); PG8_BAR;
    } else {
        PG8_STAGE(PG8_SB(0, 0), cB, voffB); PG8_STAGE(PG8_SA(0, 0), cA, voffA); PG8_STAGE(PG8_SB(0, 1), cB + hsB, voffB); PG8_STAGE(PG8_SA(0, 1), cA + hsA, voffA);
        if (wr == 1) PG8_BAR;
        PG8_WAIT_V(4); PG8_BAR;
        PG8_STAGE(PG8_SB(1, 0), cB + kstep, voffB); PG8_STAGE(PG8_SA(1, 0), cA + kstep, voffA); PG8_STAGE(PG8_SB(1, 1), cB + hsB + kstep, voffB);
        PG8_WAIT_V(6); PG8_BAR;
    }
    for (;;) {
        const bool has_next = S.next(ui + 1, nxt);
        const char* nA = has_next ? (const char*)g.A + (size_t)nxt.pm * tsA + (size_t)nxt.pn * pnA : cA; const char* nB = has_next ? (const char*)g.Bt + (size_t)nxt.pn * tsB : cB;
        for (int t = 0; t < nt; t += 2) {
            const bool last = (t == nt - 2);
            const char* a1 = cA + (size_t)(t + 1) * kstep;
            const char* a2 = last ? nA : cA + (size_t)(t + 2) * kstep; const char* b2 = last ? nB : cB + (size_t)(t + 2) * kstep;
            const char* a3 = a2 + kstep; const char* b3 = b2 + kstep;
            if (last && has_next) S.a_ready(nxt);
            if constexpr (SP2) {
            PG8_LDB(B0, 0, 0); PG8_LDB(B1, 0, 1); PG8_SCHED; PG8_LDA(At, 0, 0); PG8_STAGE(PG8_SA(1, 1), a1 + hsA, voffA);
            PG8_WAIT_V(8); PG8_WAIT_L(0); PG8_BAR; PG8_MMA(0, 0, At, B0); PG8_MMA(0, 1, At, B1); PG8_BAR; PG8_SCHED;
            PG8_LDA(At, 0, 1); PG8_STAGE(PG8_SB(0, 0), b2, voffB); PG8_STAGE(PG8_SB(0, 1), b2 + hsB, voffB); PG8_STAGE(PG8_SA(0, 0), a2, voffA);
            PG8_WAIT_V(8); PG8_WAIT_L(0); PG8_BAR; PG8_MMA(1, 0, At, B0); PG8_MMA(1, 1, At, B1); PG8_BAR; PG8_SCHED;
            PG8_LDB(B0, 1, 0); PG8_LDB(B1, 1, 1); PG8_SCHED; PG8_LDA(At, 1, 0); PG8_STAGE(PG8_SA(0, 1), a2 + hsA, voffA);
            PG8_WAIT_V(8); PG8_WAIT_L(0); PG8_BAR; PG8_MMA(0, 0, At, B0); PG8_MMA(0, 1, At, B1); PG8_BAR; PG8_SCHED;
            PG8_LDA(At, 1, 1); PG8_STAGE(PG8_SB(1, 0), b3, voffB); PG8_STAGE(PG8_SB(1, 1), b3 + hsB, voffB); PG8_STAGE(PG8_SA(1, 0), a3, voffA);
            PG8_WAIT_V(8); PG8_WAIT_L(0); PG8_BAR; PG8_MMA(1, 0, At, B0); PG8_MMA(1, 1, At, B1); PG8_BAR; PG8_SCHED;
            } else {
            PG8_LDB(B0, 0, 0); PG8_SCHED; PG8_LDA(At, 0, 0); PG8_STAGE(PG8_SA(1, 1), a1 + hsA, voffA);
            PG8_WAIT_L(8); PG8_BAR; PG8_WAIT_L(0); PG8_MMA(0, 0, At, B0); PG8_BAR; PG8_SCHED;
            PG8_LDB(B1, 0, 1); PG8_STAGE(PG8_SB(0, 0), b2, voffB);
            PG8_BAR; PG8_WAIT_L(0); PG8_MMA(0, 1, At, B1); PG8_BAR;
            PG8_LDA(At, 0, 1); PG8_STAGE(PG8_SA(0, 0), a2, voffA);
            PG8_BAR; PG8_WAIT_L(0); PG8_MMA(1, 0, At, B0); PG8_BAR; PG8_SCHED;
            PG8_STAGE(PG8_SB(0, 1), b2 + hsB, voffB);
            PG8_WAIT_V(6); PG8_BAR; PG8_MMA(1, 1, At, B1); PG8_BAR;
            PG8_LDB(B0, 1, 0); PG8_SCHED; PG8_LDA(At, 1, 0); PG8_STAGE(PG8_SA(0, 1), a2 + hsA, voffA);
            PG8_WAIT_L(8); PG8_BAR; PG8_WAIT_L(0); PG8_MMA(0, 0, At, B0); PG8_BAR; PG8_SCHED;
            PG8_LDB(B1, 1, 1); PG8_STAGE(PG8_SB(1, 0), b3, voffB);
            PG8_BAR; PG8_WAIT_L(0); PG8_MMA(0, 1, At, B1); PG8_BAR;
            PG8_LDA(At, 1, 1); PG8_STAGE(PG8_SA(1, 0), a3, voffA);
            PG8_BAR; PG8_WAIT_L(0); PG8_MMA(1, 0, At, B0); PG8_BAR; PG8_SCHED;
            PG8_STAGE(PG8_SB(1, 1), b3 + hsB, voffB);
            PG8_WAIT_V(6); PG8_BAR; PG8_MMA(1, 1, At, B1); PG8_BAR;
            }
        }
        if constexpr (ALIGN_EPI) { if (wr == 0) PG8_BAR; }
        if constexpr (!Epi::AFTER_DRAIN) { E(acc, cur, wr, wc, fr, fq, wid, lane, ui); S.done(cur); }
        if (!has_next) break;
#pragma unroll
        for (int a = 0; a < 2; ++a)
#pragma unroll
            for (int b = 0; b < 2; ++b)
#pragma unroll
                for (int m = 0; m < 4; ++m)
#pragma unroll
                    for (int n = 0; n < 2; ++n) acc[a][b][m][n] = (f32x4){0.f, 0.f, 0.f, 0.f};
        cur = nxt; cA = nA; cB = nB; ++ui;
        E.prefetch(cur, ui, wid, lane);
        if constexpr (ALIGN_EPI) { if (wr == 1) PG8_BAR; }
    }
    PG8_WAIT_V(0);
    if constexpr (!ALIGN_EPI) { if (wr == 0) PG8_BAR; }
    PG8_BAR;
    if constexpr (Epi::AFTER_DRAIN) { E.fused(acc, cur, wr, wc, fr, fq, lds, wid, lane); S.done(cur); }
#undef PG8_SA
#undef PG8_SB
#undef PG8_STAGE
#undef PG8_LDA
#undef PG8_LDB
#undef PG8_MMA
#undef PG8_WAIT_V
#undef PG8_WAIT_L
#undef PG8_BAR
#undef PG8_SCHED
}
}

#define LAS __attribute__((address_space(3)))
typedef unsigned short bf16;
typedef float f32x4 __attribute__((ext_vector_type(4)));
typedef float f32x16 __attribute__((ext_vector_type(16)));
typedef short bf16x8 __attribute__((ext_vector_type(8)));
typedef short s16x4 __attribute__((ext_vector_type(4)));
typedef unsigned u32x4 __attribute__((ext_vector_type(4)));
typedef unsigned u32x2 __attribute__((ext_vector_type(2)));

constexpr int NWAVES = 8, NT = 512;
constexpr int SEQ = 8192, DM = 1024, M = 2 * SEQ, NQKV = 1536, DFF = 2816, NUP = 5632;
constexpr size_t MiB = 1u << 20;
constexpr size_t WS_CTL = 0, CTL_ZERO_BYTES = 65536;
constexpr size_t WS_MODP = 1 * MiB;
constexpr size_t WS_MODF = WS_MODP + 8 * 2 * 2 * 6144 * 4;
constexpr size_t WS_ROPE = 2 * MiB;
constexpr size_t WS_SS = 2 * MiB + 512 * 1024;
constexpr size_t WS_GM = 2 * MiB + 768 * 1024;
constexpr size_t WS_CVEC = 2 * MiB + 832 * 1024;
constexpr size_t WS_WQKV = 3 * MiB, WS_WO = 6 * MiB, WS_WPOOL = 8 * MiB, WS_WUP = 9 * MiB, WS_WDN = 31 * MiB;
constexpr size_t WS_HALO = 42 * MiB, WS_PART = 45 * MiB;
constexpr size_t WS_X = 48 * MiB;
constexpr size_t WS_H = 112 * MiB;
constexpr size_t WS_QKV = 144 * MiB;
constexpr size_t WS_ATT = 192 * MiB;
constexpr size_t WS_ACT = 144 * MiB;
constexpr size_t WS_END = 232 * MiB;
constexpr int CW_BAR = 1024;
constexpr int RING_BYTES = 131072, XL_OFF = 131072, MISC_OFF = XL_OFF + 8192, LDS_BYTES = 155648;
constexpr float LOG2E = 1.4426950408889634f, NORM_EPS = 1e-6f;

__device__ __forceinline__ unsigned pk2(float lo, float hi) { return pg8::cvt_pk_bf16(lo, hi); }
__device__ __forceinline__ float bf_lo(unsigned u) { return __uint_as_float(u << 16); }
__device__ __forceinline__ float bf_hi(unsigned u) { return __uint_as_float(u & 0xffff0000u); }
__device__ __forceinline__ float wave_sum(float v) {
#pragma unroll
    for (int o = 1; o < 64; o <<= 1) v += __shfl_xor(v, o);
    return v;
}

#define XB_TMO      128
#define XB_XCNT(j)  (256  + 64 * (j))
#define XB_XSUB(j)  (1280 + 64 * (j))
#define XB_XGEN(j)  (2304 + 64 * (j))
#define XB_TOP      3328
#define XB_TOPGEN   3392
#define XCD_BAR_WORDS 3456
#define XB_SPIN_CAP (1u << 20)
__device__ __forceinline__ unsigned xb_ld(unsigned* p)              { return __hip_atomic_load(p, __ATOMIC_RELAXED, __HIP_MEMORY_SCOPE_AGENT); }
__device__ __forceinline__ unsigned xb_add(unsigned* p, unsigned v) { return __hip_atomic_fetch_add(p, v, __ATOMIC_RELAXED, __HIP_MEMORY_SCOPE_AGENT); }
__device__ __forceinline__ unsigned xb_xcc_id() { return (unsigned)__builtin_amdgcn_s_getreg((3 << 11) | 20) & 0xFu; }
#define XB_SPIN(cond, bar) do { unsigned _sp = 0; while (cond) { __builtin_amdgcn_s_sleep(1); \
    if ((++_sp & 255u) == 0u) { if (xb_ld(&(bar)[XB_TMO])) break; if (_sp > XB_SPIN_CAP) { atomicAdd(&(bar)[XB_TMO], 1u); break; } } } } while (0)
struct XcdBarrier { unsigned* bar; unsigned x; volatile LAS unsigned* st; };
__device__ __forceinline__ XcdBarrier xcd_barrier_post(unsigned* bar, volatile LAS unsigned* st) {
    XcdBarrier b; b.bar = bar; b.x = xb_xcc_id(); b.st = st;
    if (threadIdx.x == 0) (void)xb_add(&bar[XB_XCNT(b.x)], 1u);
    return b;
}
__device__ __forceinline__ void xcd_barrier_complete(unsigned* bar, unsigned x, unsigned& nloc, unsigned& nx) {
    const unsigned G = gridDim.x * gridDim.y * gridDim.z;
    unsigned sum, cnt, mine, sp = 0u;
    for (;;) {
        sum = 0u; cnt = 0u; mine = 0u;
#pragma unroll
        for (unsigned j = 0; j < 16; ++j) { const unsigned c = xb_ld(&bar[XB_XCNT(j)]); sum += c; cnt += (c > 0u) ? 1u : 0u; mine = (j == x) ? c : mine; }
        if (sum == G) break;
        __builtin_amdgcn_s_sleep(1);
        if ((++sp & 255u) == 0u) { if (xb_ld(&bar[XB_TMO])) break; if (sp > XB_SPIN_CAP) { atomicAdd(&bar[XB_TMO], 1u); break; } }
    }
    nloc = mine > 0u ? mine : 1u; nx = cnt > 0u ? cnt : 1u;
}
__device__ __forceinline__ void xcd_barrier(const XcdBarrier& b) {
    asm volatile("s_waitcnt vmcnt(0)" ::: "memory");
    __syncthreads();
    if (threadIdx.x == 0) {
        unsigned* bar = b.bar;
        __builtin_amdgcn_s_waitcnt(0);
        unsigned nloc = b.st[0], nx = b.st[1];
        if (nloc == 0u) { xcd_barrier_complete(bar, b.x, nloc, nx); b.st[0] = nloc; b.st[1] = nx; }
        const unsigned old = xb_add(&bar[XB_XSUB(b.x)], 1u);
        const unsigned gen = old / nloc;
        if (old + 1u == (gen + 1u) * nloc) {
            __builtin_amdgcn_fence(__ATOMIC_RELEASE, "agent");
            asm volatile("s_waitcnt vmcnt(0)" ::: "memory");
            const unsigned og = xb_add(&bar[XB_TOP], 1u);
            const unsigned tg = og / nx;
            if (og + 1u == (tg + 1u) * nx) xb_add(&bar[XB_TOPGEN], 1u);
            else XB_SPIN(xb_ld(&bar[XB_TOPGEN]) == tg, bar);
            __builtin_amdgcn_fence(__ATOMIC_ACQUIRE, "agent");
            xb_add(&bar[XB_XGEN(b.x)], 1u);
            asm volatile("s_waitcnt vmcnt(0)" ::: "memory");
        } else {
            XB_SPIN(xb_ld(&bar[XB_XGEN(b.x)]) == gen, bar);
            __builtin_amdgcn_fence(__ATOMIC_ACQUIRE, "agent");
            asm volatile("s_waitcnt vmcnt(0)" ::: "memory");
        }
    }
    __syncthreads();
}

struct Ctx { LAS unsigned char* lds; int tid, lane, wave, G, vcu; unsigned char* ws; };

__device__ __forceinline__ void transpose_item(const float* W, int K, int N, bf16* WT, int k0, int n0, int dst_row0, LAS float* scr, int lane) {
    float tv[32];
#pragma unroll
    for (int i = 0; i < 32; ++i) tv[i] = __builtin_nontemporal_load(&W[(size_t)(k0 + 2 * i + (lane >> 5)) * N + n0 + (lane & 31)]);
#pragma unroll
    for (int i = 0; i < 32; ++i) scr[(2 * i + (lane >> 5)) * 33 + (lane & 31)] = tv[i];
    asm volatile("s_waitcnt lgkmcnt(0)" ::: "memory");
    const int c = lane & 7;
#pragma unroll
    for (int j = 0; j < 4; ++j) { const int n = (lane >> 3) + 8 * j; const LAS float* s = scr + (8 * c) * 33 + n;
        u32x4 o; o.x = pk2(s[0 * 33], s[1 * 33]); o.y = pk2(s[2 * 33], s[3 * 33]); o.z = pk2(s[4 * 33], s[5 * 33]); o.w = pk2(s[6 * 33], s[7 * 33]);
        *(u32x4*)(WT + (size_t)(dst_row0 + n) * K + k0 + 8 * c) = o; }
    asm volatile("s_waitcnt lgkmcnt(0)" ::: "memory");
}

__device__ __forceinline__ void ph_prologue(const Ctx& F, const float* const* in) {
    LAS float* cact = (LAS float*)(F.lds + XL_OFF);
    const float* c = in[1];
    for (int i = F.tid; i < 2048; i += NT) { const float v = c[i]; cact[i] = v / (1.0f + __expf(-v)); }
    __syncthreads();
    const int gw = F.vcu * NWAVES + F.wave, NGW = F.G * NWAVES;
    float* MODP = (float*)(F.ws + WS_MODP);
    typedef float f32x2_ __attribute__((ext_vector_type(2)));
    for (int it = gw; it < 768; it += NGW) {
        const int i = it / 384, r = it % 384, p = r / 48, cb = r % 48;
        const float* W = in[2] + (size_t)i * 1024 * 6144 + (size_t)(p * 128) * 6144 + cb * 128 + F.lane * 2;
        f32x2_ a0 = (f32x2_){0.f, 0.f}, a1 = a0;
#pragma unroll 64
        for (int k = 0; k < 128; ++k) { const f32x2_ w = __builtin_nontemporal_load((const f32x2_*)(W + (size_t)k * 6144)); const float c0 = cact[p * 128 + k], c1 = cact[1024 + p * 128 + k]; a0 += w * c0; a1 += w * c1; }
        *(f32x2_*)(MODP + ((size_t)((p * 2 + i) * 2 + 0)) * 6144 + cb * 128 + F.lane * 2) = a0;
        *(f32x2_*)(MODP + ((size_t)((p * 2 + i) * 2 + 1)) * 6144 + cb * 128 + F.lane * 2) = a1;
    }
    LAS float* scr = (LAS float*)(F.lds + F.wave * 16384);
    for (int it = (gw + NGW - (768 % NGW)) % NGW; it < 16 * 48; it += NGW) { const int kb = it / 48, nb = it % 48; transpose_item(in[6], 1024, 1536, (bf16*)(F.ws + WS_WQKV), 64 * kb, 32 * nb, 32 * nb, scr, F.lane); }
    { float* SS = (float*)(F.ws + WS_SS); for (int idx = F.vcu * NT + F.tid; idx < 3 * M; idx += F.G * NT) SS[idx] = 0.f; }
    float* rope = (float*)(F.ws + WS_ROPE);
    for (int idx = F.vcu * NT + F.tid; idx < 65536; idx += F.G * NT) {
        const int pos = idx >> 3, i = idx & 7;
        const float invf = i == 0 ? 1.0f : i == 1 ? 0.19392274474868576f : i == 2 ? 0.03760603093086393f : i == 3 ? 0.007292664737217109f : i == 4 ? 0.001414213562373095f : i == 5 ? 0.0002742481756762073f : i == 6 ? 5.318295896944988e-05f : 1.031338537721246e-05f;
        const float ang = (float)pos * invf;
        const float k = rintf(ang * 0.15915494309189535f);
        float r = fmaf(-k, 6.28125f, ang); r = fmaf(-k, 1.9353071795864769e-3f, r);
        rope[pos * 16 + i] = __cosf(r); rope[pos * 16 + 8 + i] = __sinf(r);
    }
}

__device__ __forceinline__ void convert_rest(const Ctx& F, const float* const* in, int w, int nw, int part) {
    LAS float* scr = (LAS float*)(F.lds + F.wave * 16384);
    const int gw = w * NWAVES + F.wave, NGW = nw * NWAVES;
    constexpr int I_WO = 16 * 32, I_POOL = 4 * 4 * 8, I_UP = 16 * 176, I_DN = 44 * 32;
    constexpr int NITEMS = I_WO + I_POOL + 2 * I_UP + 2 * I_DN;
    for (int it = gw; it < NITEMS; it += NGW) {
        int r = it;
        { int q = r; const bool l1 = (q >= I_WO + I_POOL + I_UP && q < I_WO + I_POOL + 2 * I_UP) || (q >= I_WO + I_POOL + 2 * I_UP);   if ((part == 1) != l1) continue; }
        if (r < I_WO) { const int kb = r / 32, nb = r % 32; transpose_item(in[10], 1024, 1024, (bf16*)(F.ws + WS_WO), 64 * kb, 32 * nb, 32 * nb, scr, F.lane); continue; } r -= I_WO;
        if (r < I_POOL) { const int g = r / 32, q = r % 32, kb = q / 8, nb = q % 8; transpose_item(in[11] + (size_t)g * 65536, 256, 256, (bf16*)(F.ws + WS_WPOOL) + (size_t)g * 65536, 64 * kb, 32 * nb, 32 * nb, scr, F.lane); continue; } r -= I_POOL;
        if (r < 2 * I_UP) { const int l = r / I_UP, q = r % I_UP, kb = q / 176, nb = q % 176, n0 = 32 * nb;
            const int dst = n0 < DFF ? (n0 / 128) * 256 + (n0 % 128) : ((n0 - DFF) / 128) * 256 + 128 + ((n0 - DFF) % 128);
            transpose_item(in[13] + (size_t)l * 1024 * NUP, 1024, NUP, (bf16*)(F.ws + WS_WUP) + (size_t)l * NUP * 1024, 64 * kb, n0, dst, scr, F.lane); continue; } r -= 2 * I_UP;
        { const int l = r / I_DN, q = r % I_DN, kb = q / 32, nb = q % 32;
            transpose_item(in[16] + (size_t)l * DFF * 1024, DFF, 1024, (bf16*)(F.ws + WS_WDN) + (size_t)l * 1024 * DFF, 64 * kb, 32 * nb, 32 * nb, scr, F.lane); }
    }
}

template <bool FROM_PART>
__device__ __forceinline__ void ph_norm(const Ctx& F, const float* X, const float* gain, const float* mod_b_layer, int layer, int chunk, bf16* H, const float* gain_ffn) {
    LAS float* gm = (LAS float*)F.lds; LAS float* sh = gm + 1024;
    const float* MODP = (const float*)(F.ws + WS_MODP); float* MODF = (float*)(F.ws + WS_MODF);
    if (FROM_PART) {
        for (int idx = F.vcu * NT + F.tid; idx < 2 * 2 * 6144; idx += F.G * NT) { const int i = idx / 12288, rem = idx % 12288, b = rem / 6144, col = rem % 6144;
            float t = ((const float*)mod_b_layer)[(size_t)(i - layer) * 6144 + col];
#pragma unroll
            for (int p = 0; p < 8; ++p) t += MODP[((size_t)((p * 2 + i) * 2 + b)) * 6144 + col];
            MODF[idx] = t; }
        float* GM = (float*)(F.ws + WS_GM);
        for (int idx = F.vcu * NT + F.tid; idx < 2 * 2 * 1024; idx += F.G * NT) { const int i = idx >> 11, b = (idx >> 10) & 1, c = idx & 1023;
            float t = ((const float*)mod_b_layer)[(size_t)(i - layer) * 6144 + 4 * 1024 + c];
#pragma unroll
            for (int p = 0; p < 8; ++p) t += MODP[((size_t)((p * 2 + i) * 2 + b)) * 6144 + 4 * 1024 + c];
            GM[idx] = gain_ffn[i * 1024 + c] * (1.0f + t); }
    }
    for (int rb = F.vcu; rb < 256; rb += F.G) {
        const int b = rb >> 7;
        __syncthreads();
        for (int c = F.tid; c < 1024; c += NT) {
            float t, s;
            if (FROM_PART) { t = mod_b_layer[chunk * 1024 + c]; s = mod_b_layer[(chunk + 1) * 1024 + c];
#pragma unroll
                for (int p = 0; p < 8; ++p) { const float* mp = MODP + ((size_t)((p * 2 + layer) * 2 + b)) * 6144; t += mp[chunk * 1024 + c]; s += mp[(chunk + 1) * 1024 + c]; } }
            else { const float* mf = MODF + (size_t)(layer * 2 + b) * 6144; t = mf[chunk * 1024 + c]; s = mf[(chunk + 1) * 1024 + c]; }
            gm[c] = gain[c] * (1.0f + s); sh[c] = t;
        }
        __syncthreads();
#pragma unroll 4
        for (int j = 0; j < 8; ++j) {
            const int row = rb * 64 + F.wave * 8 + j;
            const f32x4* xr = (const f32x4*)(X + (size_t)row * 1024) + F.lane;
            f32x4 v[4]; float ss = 0.f;
#pragma unroll
            for (int q = 0; q < 4; ++q) { v[q] = FROM_PART ? __builtin_nontemporal_load(xr + 64 * q) : xr[64 * q]; ss += (v[q].x * v[q].x + v[q].y * v[q].y) + (v[q].z * v[q].z + v[q].w * v[q].w); }
            const float rstd = rsqrtf(wave_sum(ss) * (1.0f / 1024.0f) + NORM_EPS);
            u32x2* o8 = (u32x2*)(H + (size_t)row * 1024) + F.lane;
#pragma unroll
            for (int q = 0; q < 4; ++q) { const f32x4 g4 = *(const LAS f32x4*)(gm + 256 * q + 4 * F.lane), s4 = *(const LAS f32x4*)(sh + 256 * q + 4 * F.lane);
                const f32x4 h = v[q] * rstd * g4 + s4; u32x2 w; w.x = pk2(h.x, h.y); w.y = pk2(h.z, h.w); o8[64 * q] = w; }
        }
    }
}

template <int W>
__device__ __forceinline__ void pool_rows(const bf16* Xg, bf16* Dg, int t0, int half, const LAS float* rs, f32x4 g4, f32x4 s4) {
    f32x4 ring[W]; f32x4 sum = (f32x4){0.f, 0.f, 0.f, 0.f};
#pragma unroll
    for (int k = 0; k < W; ++k) ring[k] = (f32x4){0.f, 0.f, 0.f, 0.f};
#pragma unroll 1
    for (int c = 0; c < 3; ++c) {
        u32x2 xr[16];
#pragma unroll
        for (int i = 0; i < 16; ++i) { const int jj = 16 * c + i, t = t0 - 15 + 32 * half + jj; xr[i] = (u32x2){0u, 0u}; if (jj < 47 && t >= 0) xr[i] = *(const u32x2*)(Xg + (size_t)t * 1024); }
#pragma unroll
        for (int i = 0; i < 16; ++i) {
            const int jj = 16 * c + i, j = 32 * half + jj, t = t0 - 15 + j;
            if (jj < 47) {
                const f32x4 xv = (f32x4){bf_lo(xr[i].x), bf_hi(xr[i].x), bf_lo(xr[i].y), bf_hi(xr[i].y)};
                f32x4 h = xv * rs[j] * g4 + s4;
                if (t < 0) h = (f32x4){0.f, 0.f, 0.f, 0.f};
                sum = sum + h - ring[W - 1];
#pragma unroll
                for (int k = W - 1; k > 0; --k) ring[k] = ring[k - 1];
                ring[0] = h;
                if (jj >= 15) {
                    const float inv = 1.0f / (float)((t + 1) < W ? (t + 1) : W);
                    const f32x4 d = sum * inv - h;
                    u32x2 w; w.x = pk2(d.x, d.y); w.y = pk2(d.z, d.w);
                    *(u32x2*)(Dg + (size_t)t * 1024) = w;
                }
            }
        }
    }
}
__device__ __forceinline__ void ph_pooldiff(const Ctx& F, const bf16* X, const float* gain, int layer, bf16* D, const float* SSQ) {
    LAS float* gm = (LAS float*)F.lds; LAS float* sh = gm + 1024; LAS float* rs = sh + 1024;
    const float* MODF = (const float*)(F.ws + WS_MODF);
    for (int rb = F.vcu; rb < 256; rb += F.G) {
        const int b = rb >> 7, t0 = (rb & 127) * 64;
        __syncthreads();
        for (int c = F.tid; c < 1024; c += NT) { const float* mf = MODF + (size_t)(layer * 2 + b) * 6144; gm[c] = gain[c] * (1.0f + mf[1024 + c]); sh[c] = mf[c]; }
        for (int j = F.tid; j < 79; j += NT) { const int t = t0 - 15 + j; rs[j] = t >= 0 ? rsqrtf(SSQ[(size_t)b * SEQ + t] * (1.0f / 1024.0f) + NORM_EPS) : 0.f; }
        __syncthreads();
        const int g = F.wave & 3, half = F.wave >> 2;
        const f32x4 g4 = *(const LAS f32x4*)(gm + 256 * g + 4 * F.lane), s4 = *(const LAS f32x4*)(sh + 256 * g + 4 * F.lane);
        const bf16* Xg = X + (size_t)b * SEQ * 1024 + 256 * g + 4 * F.lane; bf16* Dg = D + (size_t)b * SEQ * 1024 + 256 * g + 4 * F.lane;
        if (g == 0) pool_rows<2>(Xg, Dg, t0, half, rs, g4, s4); else if (g == 1) pool_rows<4>(Xg, Dg, t0, half, rs, g4, s4);
        else if (g == 2) pool_rows<8>(Xg, Dg, t0, half, rs, g4, s4); else pool_rows<16>(Xg, Dg, t0, half, rs, g4, s4);
    }
}

__device__ __forceinline__ int crow(int r, int hi) { return (r & 3) + 8 * (r >> 2) + 4 * hi; }
__device__ __forceinline__ void ph_attn(const Ctx& F, const bf16* QKV, const float* qgain, const float* kgain, const float* sinks, bf16* ATT) {
    constexpr int KS = 144, VS = 528;
    LAS unsigned char* Ks = F.lds; LAS unsigned char* Vt = F.lds + 256 * KS;
    LAS float* QR = (LAS float*)(F.lds + 256 * KS + 64 * VS);
    LAS float* GN = QR + 128 * 16;
    const float* rope = (const float*)(F.ws + WS_ROPE);
    if (F.tid < 128) GN[F.tid] = F.tid < 64 ? qgain[F.tid] : kgain[F.tid - 64];
    const int r32 = F.lane & 31, hi = F.lane >> 5;
    for (int u = F.vcu; u < 512; u += F.G) {
        const int b = u >> 8, n = (u >> 2) & 63, hk = u & 3;
        const int tok0 = b * SEQ + n * 128;
        __syncthreads();
        const int g = F.wave >> 1, qh = F.wave & 1, hq = hk * 4 + g;
        u32x4 kraw[4], vraw[4]; f32x4 rcs[4][4];
#pragma unroll
        for (int i = 0; i < 4; ++i) {
            const int item = F.tid + NT * i, key = item >> 3, c = item & 7;
            const int pos = n * 128 - 128 + key;
            kraw[i] = (u32x4){0u, 0u, 0u, 0u}; vraw[i] = kraw[i];
            if (pos >= 0) { const bf16* rowp = QKV + (size_t)(b * SEQ + pos) * NQKV; kraw[i] = *(const u32x4*)(rowp + 1024 + hk * 64 + 8 * c); vraw[i] = *(const u32x4*)(rowp + 1280 + hk * 64 + 8 * c); }
            if (c < 2) { const f32x4* rp = (const f32x4*)(rope + (size_t)(pos >= 0 ? pos : 0) * 16); rcs[i][0] = rp[0]; rcs[i][1] = rp[1]; rcs[i][2] = rp[2]; rcs[i][3] = rp[3]; }
        }
        const f32x4 qrr = *(const f32x4*)(rope + (size_t)(n * 128) * 16 + F.tid * 4);
        u32x4 qnext[4];
        { const bf16* qrow = QKV + (size_t)(tok0 + 64 * qh + r32) * NQKV + hq * 64;
#pragma unroll
          for (int d0 = 0; d0 < 4; ++d0) qnext[d0] = *(const u32x4*)(qrow + 16 * d0 + 8 * hi); }
#pragma unroll
        for (int i = 0; i < 4; ++i) {
            const int item = F.tid + NT * i, key = item >> 3, c = item & 7;
            float kf[8], pf[8];
#pragma unroll
            for (int e = 0; e < 4; ++e) { kf[2 * e] = bf_lo(kraw[i][e]); kf[2 * e + 1] = bf_hi(kraw[i][e]); }
            float ss = 0.f;
#pragma unroll
            for (int e = 0; e < 8; ++e) ss += kf[e] * kf[e];
            ss += __shfl_xor(ss, 1); ss += __shfl_xor(ss, 2); ss += __shfl_xor(ss, 4);
            const float rstd = rsqrtf(ss * (1.0f / 64.0f) + NORM_EPS);
#pragma unroll
            for (int e = 0; e < 8; ++e) kf[e] *= rstd * GN[64 + 8 * c + e];
#pragma unroll
            for (int e = 0; e < 8; ++e) pf[e] = __shfl_xor(kf[e], 1);
            if (c < 2) {
#pragma unroll
                for (int e = 0; e < 8; ++e) { const float cs = rcs[i][e >> 2][e & 3], sn = rcs[i][2 + (e >> 2)][e & 3]; kf[e] = (c == 0) ? kf[e] * cs - pf[e] * sn : kf[e] * cs + pf[e] * sn; }
            }
            u32x4 ko; ko.x = pk2(kf[0], kf[1]); ko.y = pk2(kf[2], kf[3]); ko.z = pk2(kf[4], kf[5]); ko.w = pk2(kf[6], kf[7]);
            *(LAS u32x4*)(Ks + key * KS + c * 16) = ko;
#pragma unroll
            for (int e = 0; e < 4; ++e) {
                *(LAS unsigned short*)(Vt + (8 * c + 2 * e) * VS + key * 2) = (unsigned short)(vraw[i][e] & 0xffffu);
                *(LAS unsigned short*)(Vt + (8 * c + 2 * e + 1) * VS + key * 2) = (unsigned short)(vraw[i][e] >> 16);
            }
        }
        *(LAS f32x4*)(QR + F.tid * 4) = qrr;
        __syncthreads();
        const float sink2 = sinks[hq] * LOG2E;
#pragma unroll 1
        for (int qb = 0; qb < 2; ++qb) {
            const int q0 = 64 * qh + 32 * qb;
            float qf[4][8]; float ss = 0.f;
            u32x4 qcur[4];
#pragma unroll
            for (int d0 = 0; d0 < 4; ++d0) qcur[d0] = qnext[d0];
            if (qb == 0) { const bf16* qrow = QKV + (size_t)(tok0 + q0 + 32 + r32) * NQKV + hq * 64;
#pragma unroll
                for (int d0 = 0; d0 < 4; ++d0) qnext[d0] = *(const u32x4*)(qrow + 16 * d0 + 8 * hi); }
#pragma unroll
            for (int d0 = 0; d0 < 4; ++d0) { const u32x4 raw = qcur[d0];
#pragma unroll
                for (int e = 0; e < 4; ++e) { qf[d0][2 * e] = bf_lo(raw[e]); qf[d0][2 * e + 1] = bf_hi(raw[e]); } }
#pragma unroll
            for (int d0 = 0; d0 < 4; ++d0)
#pragma unroll
                for (int e = 0; e < 8; ++e) ss += qf[d0][e] * qf[d0][e];
            ss += __shfl_xor(ss, 32);
            const float rstd = rsqrtf(ss * (1.0f / 64.0f) + NORM_EPS);
#pragma unroll
            for (int d0 = 0; d0 < 4; ++d0)
#pragma unroll
                for (int e = 0; e < 8; ++e) qf[d0][e] *= rstd * GN[16 * d0 + 8 * hi + e];
            {
                const LAS float* rp = QR + (q0 + r32) * 16;
#pragma unroll
                for (int e = 0; e < 8; ++e) { const float pf = __shfl_xor(qf[0][e], 32); const float cs = rp[e], sn = rp[8 + e]; qf[0][e] = (hi == 0) ? qf[0][e] * cs - pf * sn : qf[0][e] * cs + pf * sn; }
            }
            bf16x8 qfr[4];
#pragma unroll
            for (int d0 = 0; d0 < 4; ++d0) { u32x4 w; const float sc = 0.125f * LOG2E;
                w.x = pk2(qf[d0][0] * sc, qf[d0][1] * sc); w.y = pk2(qf[d0][2] * sc, qf[d0][3] * sc); w.z = pk2(qf[d0][4] * sc, qf[d0][5] * sc); w.w = pk2(qf[d0][6] * sc, qf[d0][7] * sc);
                qfr[d0] = __builtin_bit_cast(bf16x8, w); }
            f32x16 S[5];
#pragma unroll
            for (int kb = 0; kb < 5; ++kb) {
                S[kb] = (f32x16){0.f, 0.f, 0.f, 0.f, 0.f, 0.f, 0.f, 0.f, 0.f, 0.f, 0.f, 0.f, 0.f, 0.f, 0.f, 0.f};
#pragma unroll
                for (int d0 = 0; d0 < 4; ++d0) { const bf16x8 a = *(const LAS bf16x8*)(Ks + (q0 + 32 * kb + r32) * KS + (16 * d0 + 8 * hi) * 2);
                    S[kb] = __builtin_amdgcn_mfma_f32_32x32x16_bf16(a, qfr[d0], S[kb], 0, 0, 0); }
            }
            const float NEG = -1e30f;
#pragma unroll
            for (int r = 0; r < 16; ++r) { if (crow(r, hi) <= r32) S[0][r] = NEG; if (crow(r, hi) > r32) S[4][r] = NEG; }
            if (n == 0) {
#pragma unroll
                for (int kb = 0; kb < 5; ++kb)
#pragma unroll
                    for (int r = 0; r < 16; ++r) if (q0 + 32 * kb + crow(r, hi) < 128) S[kb][r] = NEG;
            }
            float mx = sink2;
#pragma unroll
            for (int kb = 0; kb < 5; ++kb)
#pragma unroll
                for (int r = 0; r < 16; ++r) mx = fmaxf(mx, S[kb][r]);
            mx = fmaxf(mx, __shfl_xor(mx, 32));
            float sum = 0.f;
#pragma unroll
            for (int kb = 0; kb < 5; ++kb)
#pragma unroll
                for (int r = 0; r < 16; ++r) { const float p = __builtin_amdgcn_exp2f(S[kb][r] - mx); S[kb][r] = p; sum += p; }
            sum += __shfl_xor(sum, 32);
            sum += __builtin_amdgcn_exp2f(sink2 - mx);
            const float inv = 1.0f / sum;
            f32x16 O[2];
            O[0] = (f32x16){0.f, 0.f, 0.f, 0.f, 0.f, 0.f, 0.f, 0.f, 0.f, 0.f, 0.f, 0.f, 0.f, 0.f, 0.f, 0.f}; O[1] = O[0];
#pragma unroll
            for (int kb = 0; kb < 5; ++kb)
#pragma unroll
                for (int hf = 0; hf < 2; ++hf) {
                    u32x4 pw; pw.x = pk2(S[kb][8 * hf + 0], S[kb][8 * hf + 1]); pw.y = pk2(S[kb][8 * hf + 2], S[kb][8 * hf + 3]); pw.z = pk2(S[kb][8 * hf + 4], S[kb][8 * hf + 5]); pw.w = pk2(S[kb][8 * hf + 6], S[kb][8 * hf + 7]);
                    const bf16x8 pfrag = __builtin_bit_cast(bf16x8, pw);
                    const int base = q0 + 32 * kb + 16 * hf;
#pragma unroll
                    for (int db = 0; db < 2; ++db) {
                        const u32x2 lo = *(const LAS u32x2*)(Vt + (32 * db + r32) * VS + (base + 4 * hi) * 2), hi2 = *(const LAS u32x2*)(Vt + (32 * db + r32) * VS + (base + 8 + 4 * hi) * 2);
                        u32x4 vw; vw.x = lo.x; vw.y = lo.y; vw.z = hi2.x; vw.w = hi2.y;
                        O[db] = __builtin_amdgcn_mfma_f32_32x32x16_bf16(__builtin_bit_cast(bf16x8, vw), pfrag, O[db], 0, 0, 0);
                    }
                }
            bf16* orow = ATT + (size_t)(tok0 + q0 + r32) * 1024 + hq * 64;
#pragma unroll
            for (int db = 0; db < 2; ++db)
#pragma unroll
                for (int rg = 0; rg < 4; ++rg) { u32x2 w; w.x = pk2(O[db][4 * rg] * inv, O[db][4 * rg + 1] * inv); w.y = pk2(O[db][4 * rg + 2] * inv, O[db][4 * rg + 3] * inv);
                    *(u32x2*)(orow + 32 * db + 8 * rg + 4 * hi) = w; }
        }
    }
}

__device__ __forceinline__ void cvec_job(const Ctx& F, int l) {
    const float* MODF = (const float*)(F.ws + WS_MODF); float* CV = (float*)(F.ws + WS_CVEC);
    const int gw = F.vcu * NWAVES + F.wave, NGW = F.G * NWAVES;
    for (int r = gw; r < NUP; r += NGW) {
        const bf16* wrow = (const bf16*)(F.ws + WS_WUP) + ((size_t)l * NUP + r) * 1024;
        float d0 = 0.f, d1 = 0.f;
#pragma unroll
        for (int h = 0; h < 2; ++h) { const int k0 = h * 512 + F.lane * 8; const u32x4 w = *(const u32x4*)(wrow + k0);
            const float* s0 = MODF + (size_t)(l * 2 + 0) * 6144 + 3 * 1024 + k0; const float* s1 = MODF + (size_t)(l * 2 + 1) * 6144 + 3 * 1024 + k0;
#pragma unroll
            for (int e = 0; e < 4; ++e) { const float wl = bf_lo(w[e]), wh = bf_hi(w[e]); d0 += wl * s0[2 * e] + wh * s0[2 * e + 1]; d1 += wl * s1[2 * e] + wh * s1[2 * e + 1]; } }
        d0 = wave_sum(d0); d1 = wave_sum(d1);
        if (F.lane == 0) { CV[(size_t)(l * 2 + 0) * NUP + r] = d0; CV[(size_t)(l * 2 + 1) * NUP + r] = d1; }
    }
}

__device__ __forceinline__ void fixup_tile(const Ctx& F, const float* cw, bf16* ACT, int pm) {
    if ((pm & 31) == 0) return;
    const float* HALO = (const float*)(F.ws + WS_HALO); const float* PART = (const float*)(F.ws + WS_PART);
    static_assert(2 * DFF == 11 * NT, "fixup_tile: 11 outputs per thread");
#pragma unroll
    for (int it = 0; it < 11; ++it) {
        const int idx = F.tid + it * NT;
        const int fr = idx / DFF, j = idx % DFF;
        const float* hb = HALO + (size_t)((pm - 1) * 2) * NUP; const float* pb = PART + (size_t)(pm * 2 + fr) * NUP;
        float g = pb[j], v = pb[DFF + j];
        const float h0g = hb[j], h1g = hb[NUP + j], h0v = hb[DFF + j], h1v = hb[NUP + DFF + j];
        if (fr == 0) { g += cw[NUP + j] * h1g + cw[j] * h0g; v += cw[NUP + DFF + j] * h1v + cw[DFF + j] * h0v; }
        else { g += cw[j] * h1g; v += cw[DFF + j] * h1v; }
        const float a = pg8::silu_f(g) * v;
        ACT[(size_t)(pm * 256 + fr) * DFF + j] = (bf16)(pk2(a, a) & 0xffffu);
    }
}

struct Args { const float* in[17]; float* out; unsigned char* ws; int ph_lo, ph_hi, use_cg, pad; };
constexpr int NPHASE = 11;

__global__ void __launch_bounds__(NT, 2) fwd_kernel(Args args) {
    extern __shared__ __attribute__((aligned(16))) unsigned char lds_raw[];
    Ctx F;
    F.lds = (LAS unsigned char*)lds_raw; F.tid = threadIdx.x; F.lane = F.tid & 63; F.wave = __builtin_amdgcn_readfirstlane(F.tid >> 6);
    F.G = gridDim.x; { const int bx = blockIdx.x; F.vcu = (F.G % 8 == 0) ? (bx % 8) * (F.G / 8) + bx / 8 : bx; }
    F.ws = args.ws;
    unsigned icw = 0u;
    { const unsigned long long pc = ((unsigned long long)__builtin_amdgcn_s_getpc()) & ~15ull;
      if (F.tid < 360) { const u32x4 cv = *(const volatile u32x4*)(pc + (unsigned long long)(((int)blockIdx.x >> 3) & 31) * 5760ull + (unsigned long long)F.tid * 16ull); icw = cv.x ^ cv.y ^ cv.z ^ cv.w; } }
    volatile LAS unsigned* MISC = (volatile LAS unsigned*)(F.lds + MISC_OFF);
    if (F.tid < 16) MISC[F.tid] = 0u;
    __syncthreads();
    XcdBarrier bar = xcd_barrier_post((unsigned*)(F.ws + WS_CTL) + CW_BAR, MISC + 8);
    const int lo = args.ph_lo, hi = args.ph_hi;
#ifndef PHASE_MASK
#define PHASE_MASK 0x7ff
#endif
#define IN(k) (((PHASE_MASK >> (k)) & 1) && lo <= (k) && (k) < hi)
#ifndef DUP_BAR
#define DUP_BAR 0
#endif
#ifndef DUP_MASK
#define DUP_MASK 0
#endif
#define REP(k) for (int rep_ = 0; rep_ < 1 + ((DUP_MASK >> (k)) & 1); ++rep_)
#define SEAM(k) do { if (IN(k) && IN((k) + 1)) { if (args.use_cg) cg::this_grid().sync(); else { xcd_barrier(bar); if (DUP_BAR) xcd_barrier(bar); } } } while (0)
    const float* const* in = args.in;
      bf16* X = (bf16*)(F.ws + WS_X); bf16* H = (bf16*)(F.ws + WS_H); bf16* QKV = (bf16*)(F.ws + WS_QKV); bf16* ATT = (bf16*)(F.ws + WS_ATT); bf16* ACT = (bf16*)(F.ws + WS_ACT);
    const float* MODF = (const float*)(F.ws + WS_MODF);
    LAS unsigned char* xl = F.lds + XL_OFF;

    float* SS = (float*)(F.ws + WS_SS); const float* GM = (const float*)(F.ws + WS_GM); const float* CV = (const float*)(F.ws + WS_CVEC);
    if (IN(0)) REP(0) ph_prologue(F, in);
    if (icw == 0x9E3779B9u && args.use_cg) ((unsigned*)(F.ws + WS_CTL + 61440))[F.tid] = icw;
    SEAM(0);
    if (IN(1)) REP(1) ph_norm<true>(F, in[0], in[4], in[3], 0, 0, H, in[5]);
    SEAM(1);
    if (IN(2)) { pg8::Gemm g{H, (const bf16*)(F.ws + WS_WQKV), 1024, 1024, 1024, 0}; pg8::StaticOrder S; S.init(M, NQKV, F.G, (int)blockIdx.x);
        pg8::EpiBf16 E{QKV, NQKV}; pg8::gemm_phase<pg8::EpiBf16, pg8::StaticOrder, true, true>(F.lds, g, S, E);
        if ((DUP_MASK >> 2) & 1) { __syncthreads(); pg8::gemm_phase<pg8::EpiBf16, pg8::StaticOrder, true, true>(F.lds, g, S, E); }
        { const int nwg = (M / 256) * (NQKV / 256), rounds = (nwg + F.G - 1) / F.G, nidle = rounds * F.G - nwg, c = (int)blockIdx.x;
          __syncthreads();
          if (nidle == 0) convert_rest(F, in, c, F.G, 0); else if (c >= F.G - nidle) convert_rest(F, in, c - (F.G - nidle), nidle, 0); } }
    SEAM(2);
    if (IN(3)) { REP(3) ph_attn(F, QKV, in[7], in[8], in[9], ATT); cvec_job(F, 0); }
    SEAM(3);
    if (IN(4)) { pg8::Gemm g{ATT, (const bf16*)(F.ws + WS_WO), 1024, 1024, 1024, 0}; pg8::StaticOrder S; S.init(M, 1024, F.G, (int)blockIdx.x);
        pg8::EpiRes<true, true, false, true> E{in[0], X, MODF + 0 * 12288 + 2 * 1024, nullptr, H, GM, SS}; pg8::gemm_phase<pg8::EpiRes<true, true, false, true>, pg8::StaticOrder, true, true>(F.lds, g, S, E); }
    SEAM(4);
#define UP(l, ph) do { if (IN(ph)) { pg8::Gemm g{H, (const bf16*)(F.ws + WS_WUP) + (size_t)(l) * NUP * 1024, 1024, 1024, 1024, 0}; pg8::StaticOrder S; S.init(M, NUP, F.G, (int)blockIdx.x); \
            pg8::EpiUp E{ACT, in[14] + (size_t)(l) * 3 * NUP, in[15] + (size_t)(l) * NUP, (float*)(F.ws + WS_HALO), (float*)(F.ws + WS_PART), xl, SS + (size_t)(2 * (l)) * M, CV + (size_t)(l) * 2 * NUP}; \
            pg8::gemm_phase<pg8::EpiUp, pg8::StaticOrder, true, true>(F.lds, g, S, E); \
            if ((l) == 0) { const int nwg = (M / 256) * (NUP / 256), rounds = (nwg + F.G - 1) / F.G, nidle = rounds * F.G - nwg, c = (int)blockIdx.x; __syncthreads(); \
                if (nidle == 0) convert_rest(F, in, c, F.G, 1); else if (c >= F.G - nidle) convert_rest(F, in, c - (F.G - nidle), nidle, 1); } } } while (0)
#define DOWN_PRE(l) pg8::Gemm g{ACT, (const bf16*)(F.ws + WS_WDN) + (size_t)(l) * 1024 * DFF, DFF, DFF, DFF, 0}; pg8::StaticOrder S; S.init(M, 1024, F.G, (int)blockIdx.x); \
            { pg8::Unit fu; for (int fi = 0; S.next(fi, fu); ++fi) fixup_tile(F, in[14] + (size_t)(l) * 3 * NUP, ACT, fu.pm); asm volatile("s_waitcnt vmcnt(0)" ::: "memory"); __syncthreads(); }
    UP(0, 5);
    SEAM(5);
    if (IN(6)) { DOWN_PRE(0)
        pg8::EpiRes<false, true, true, true> E{X, X, MODF + 0 * 12288 + 5 * 1024, nullptr, nullptr, nullptr, SS + M}; pg8::gemm_phase<pg8::EpiRes<false, true, true, true>, pg8::StaticOrder, true, true>(F.lds, g, S, E); }
    SEAM(6);
    if (IN(7)) { REP(7) ph_pooldiff(F, X, in[4] + 1024, 1, ATT, SS + M); cvec_job(F, 1); }
    SEAM(7);
    if (IN(8)) { pg8::Gemm g{ATT, (const bf16*)(F.ws + WS_WPOOL), 1024, 256, 256, 256}; pg8::StaticOrder S; S.init(M, 1024, F.G, (int)blockIdx.x);
        pg8::EpiRes<true, true, true, true> E{X, X, MODF + 1 * 12288 + 2 * 1024, in[12], H, GM + 2048, SS + 2 * M}; pg8::gemm_phase<pg8::EpiRes<true, true, true, true>, pg8::StaticOrder, true, true>(F.lds, g, S, E); }
    SEAM(8);
    UP(1, 9);
    SEAM(9);
    if (IN(10)) { DOWN_PRE(1)
        pg8::EpiRes<false, false, true, false> E{X, args.out, MODF + 1 * 12288 + 5 * 1024, nullptr, nullptr, nullptr, nullptr}; pg8::gemm_phase<pg8::EpiRes<false, false, true, false>, pg8::StaticOrder, true, true>(F.lds, g, S, E); }
#undef UP
#undef DOWN_PRE
#undef IN
#undef SEAM
}

extern "C" void kernel_launch(void* const* d_in, const int* in_sizes, int n_in, void* d_out, int out_size, void* d_ws, size_t ws_size, hipStream_t stream) {
    static int grid = 0;
    if (grid == 0) {
        if (n_in != 17 || out_size != M * DM || ws_size < WS_END) { fprintf(stderr, "kernel_launch: unexpected shapes (n_in %d out %d ws %zu)\n", n_in, out_size, ws_size); grid = -1; return; }
        int dev = 0, cus = 0, per_cu = 0;
        if (hipGetDevice(&dev) != hipSuccess || hipDeviceGetAttribute(&cus, hipDeviceAttributeMultiprocessorCount, dev) != hipSuccess) { grid = -1; return; }
        if (hipFuncSetAttribute((const void*)fwd_kernel, hipFuncAttributeMaxDynamicSharedMemorySize, LDS_BYTES) != hipSuccess) { fprintf(stderr, "kernel_launch: hipFuncSetAttribute failed\n"); grid = -1; return; }
        if (hipOccupancyMaxActiveBlocksPerMultiprocessor(&per_cu, (const void*)fwd_kernel, NT, LDS_BYTES) != hipSuccess || per_cu < 1) { fprintf(stderr, "kernel_launch: occupancy query says %d\n", per_cu); per_cu = 1; }
        (void)hipGetLastError();
        grid = cus * 1;
    }
    if (grid < 0) return;
    (void)hipMemsetAsync((char*)d_ws + WS_CTL, 0, CTL_ZERO_BYTES, stream);
    Args a{};
    for (int i = 0; i < 17; ++i) a.in[i] = (const float*)d_in[i];
    a.out = (float*)d_out; a.ws = (unsigned char*)d_ws; a.ph_lo = 0; a.ph_hi = NPHASE; a.use_cg = 0; a.pad = 0;
    void* kargs[] = {&a};
    hipError_t e = hipLaunchCooperativeKernel((const void*)fwd_kernel, dim3(grid), dim3(NT), kargs, LDS_BYTES, stream);
    if (e != hipSuccess) fprintf(stderr, "kernel_launch: cooperative launch failed: %s (grid %d)\n", hipGetErrorString(e), grid);
}
```

```cpp
#include <hip/hip_runtime.h>
#include <hip/hip_cooperative_groups.h>
#include <cstdio>
#include <cstdint>
namespace cg = cooperative_groups;

namespace pg8 {
#define PG8_LAS __attribute__((address_space(3)))
typedef unsigned short bf16_t;
typedef short bf16x8 __attribute__((ext_vector_type(8)));
typedef float f32x4 __attribute__((ext_vector_type(4)));
typedef unsigned u32x4 __attribute__((ext_vector_type(4)));
constexpr int BM = 256, BK = 64, HALF = 128, HTB = HALF * BK * 2  , STAGE_BYTES = 8 * HTB, NXCD = 8, WGM = 8;

__host__ __device__ __forceinline__ int lds_byte(int r, int c) { const int st = (r >> 4) * 2 + (c >> 5), rr = r & 15, cc = c & 31, ob = rr * 64 + cc * 2; return st * 1024 + (ob ^ (((ob >> 9) & 1) << 5)); }
__host__ __device__ __forceinline__ void stage_rc(int b, int& R, int& C) { const int st = b / 1024, sb = b % 1024, swz = sb ^ (((sb >> 9) & 1) << 5); R = (st >> 1) * 16 + swz / 64; C = (st & 1) * 32 + (swz % 64) / 2; }
__host__ __device__ __forceinline__ int perm32(int rho) { const int n = rho >> 4, i = rho & 15; return 8 * (i >> 2) + 4 * n + (i & 3); }

struct Unit { int pm, pn; };
struct Gemm { const bf16_t* A; const bf16_t* Bt; int lda, ldb, K, a_pn_off; };

struct StaticOrder {
    int nM, nN, nwg, G, c;
    __host__ __device__ void init(int M, int N, int G_, int c_) { nM = M / BM; nN = N / BM; nwg = nM * nN; G = G_; c = c_; }
    __host__ __device__ __forceinline__ bool next(int i, Unit& u) const {
        const long L = (long)i * G + c; if (L >= nwg) return false;
        int wgid = (int)L; { const int q = nwg / NXCD, r = nwg % NXCD, xcd = wgid % NXCD, off = wgid / NXCD; wgid = (xcd < r ? xcd * (q + 1) : r * (q + 1) + (xcd - r) * q) + off; }
        const int nig = WGM * nN, gid = wgid / nig, fm = gid * WGM, gsz = (nM - fm) < WGM ? (nM - fm) : WGM;
        u.pm = fm + ((wgid % nig) % gsz); u.pn = (wgid % nig) / gsz; return true;
    }
    __device__ __forceinline__ void a_ready(const Unit&) const {}
    __device__ __forceinline__ void done(const Unit&) const {}
};

__device__ __forceinline__ unsigned cvt_pk_bf16(float lo, float hi) { unsigned r; asm volatile("v_cvt_pk_bf16_f32 %0, %1, %2" : "=v"(r) : "v"(lo), "v"(hi)); return r; }
template <int CTRL> __device__ __forceinline__ float dppf(float v) { return __builtin_bit_cast(float, __builtin_amdgcn_update_dpp(0, __builtin_bit_cast(int, v), CTRL, 0xf, 0xf, true)); }
__device__ __forceinline__ float silu_f(float g) { return g * __builtin_amdgcn_rcpf(1.0f + __builtin_amdgcn_exp2f(-1.4426950408889634f * g)); }


struct EpiBf16 {
    static constexpr bool PERM = true, AFTER_DRAIN = false;
    bf16_t* O; int ldc;
    __device__ __forceinline__ void prefetch(const Unit&, int, int, int) const {}
    __device__ __forceinline__ void operator()(f32x4 (&acc)[2][2][4][2], const Unit& u, int wr, int wc, int fr, int fq, int wid, int lane, int ui) const {
        const int row0 = u.pm * BM + wr * 64 + fr, col0 = u.pn * BM + wc * 32 + 8 * fq;
#pragma unroll
        for (int ai = 0; ai < 2; ++ai)
#pragma unroll
            for (int m = 0; m < 4; ++m) { bf16_t* rowp = O + (size_t)(row0 + ai * HALF + m * 16) * ldc + col0;
#pragma unroll
                for (int bj = 0; bj < 2; ++bj) { const f32x4 v0 = acc[ai][bj][m][0], v1 = acc[ai][bj][m][1];
                    u32x4 w; w.x = cvt_pk_bf16(v0[0], v0[1]); w.y = cvt_pk_bf16(v0[2], v0[3]); w.z = cvt_pk_bf16(v1[0], v1[1]); w.w = cvt_pk_bf16(v1[2], v1[3]);
                    *(u32x4*)(rowp + bj * HALF) = w; } }
    }
};

template <bool WA, bool WS, bool BB  , bool OB  >
struct EpiRes {
    static constexpr bool PERM = true, AFTER_DRAIN = false, NTB = !BB || !OB;
    const void* base; void* out; const float* gate  ; const float* cscale  ;
    bf16_t* An; const float* gmul  ; float* ss  ;
    __device__ __forceinline__ void prefetch(const Unit&, int, int, int) const {}
    __device__ __forceinline__ void operator()(f32x4 (&acc)[2][2][4][2], const Unit& u, int wr, int wc, int fr, int fq, int wid, int lane, int ui) const {
        const int col0 = u.pn * BM + wc * 32 + 8 * fq; const int b = u.pm >> 5;
        f32x4 gv[2][2];
#pragma unroll
        for (int bj = 0; bj < 2; ++bj)
#pragma unroll
            for (int n = 0; n < 2; ++n) { const int c = col0 + bj * HALF + n * 4; f32x4 g = *(const f32x4*)(gate + (size_t)b * 6144 + c); if (cscale) g = g * *(const f32x4*)(cscale + c); gv[bj][n] = g; }
        constexpr int NB = (WA && BB) ? 1 : 2;
#pragma unroll
        for (int hq_ = 0; hq_ < 8 / NB; ++hq_) {
            const int ai = (hq_ * NB) >> 2, m0 = (hq_ * NB) & 3;
            const int rowb = u.pm * BM + ai * HALF + wr * 64 + fr;
            f32x4 pre[NB][2][2]; u32x4 preb[NB][2];
#pragma unroll
            for (int mm = 0; mm < NB; ++mm)
#pragma unroll
                for (int bj = 0; bj < 2; ++bj) {
                    const size_t o_ = (size_t)(rowb + (m0 + mm) * 16) * 1024 + col0 + bj * HALF;
                    if (BB) preb[mm][bj] = NTB ? __builtin_nontemporal_load((const u32x4*)((const bf16_t*)base + o_)) : *(const u32x4*)((const bf16_t*)base + o_);
                    else { pre[mm][bj][0] = NTB ? __builtin_nontemporal_load((const f32x4*)((const float*)base + o_)) : *(const f32x4*)((const float*)base + o_);
                           pre[mm][bj][1] = NTB ? __builtin_nontemporal_load((const f32x4*)((const float*)base + o_ + 4)) : *(const f32x4*)((const float*)base + o_ + 4); } }
            asm volatile("" ::: "memory");
            float sq[NB];
#pragma unroll
            for (int mm = 0; mm < NB; ++mm) { sq[mm] = 0.f;
#pragma unroll
                for (int bj = 0; bj < 2; ++bj) {
                    if (BB) { const u32x4 w = preb[mm][bj];
                        pre[mm][bj][0] = (f32x4){__uint_as_float(w.x << 16), __uint_as_float(w.x & 0xffff0000u), __uint_as_float(w.y << 16), __uint_as_float(w.y & 0xffff0000u)};
                        pre[mm][bj][1] = (f32x4){__uint_as_float(w.z << 16), __uint_as_float(w.z & 0xffff0000u), __uint_as_float(w.w << 16), __uint_as_float(w.w & 0xffff0000u)}; }
#pragma unroll
                    for (int n = 0; n < 2; ++n) { const f32x4 o = pre[mm][bj][n] + gv[bj][n] * acc[ai][bj][m0 + mm][n]; acc[ai][bj][m0 + mm][n] = o;
                        if (WS) sq[mm] += (o[0] * o[0] + o[1] * o[1]) + (o[2] * o[2] + o[3] * o[3]); } } }
            asm volatile("" ::: "memory");
#pragma unroll
            for (int mm = 0; mm < NB; ++mm) { const int m = m0 + mm; const size_t off = (size_t)(rowb + m * 16) * 1024 + col0;
#pragma unroll
                for (int bj = 0; bj < 2; ++bj) {
                    if (OB) { const f32x4 a0 = acc[ai][bj][m][0], a1 = acc[ai][bj][m][1]; u32x4 w; w.x = cvt_pk_bf16(a0[0], a0[1]); w.y = cvt_pk_bf16(a0[2], a0[3]); w.z = cvt_pk_bf16(a1[0], a1[1]); w.w = cvt_pk_bf16(a1[2], a1[3]);
                        *(u32x4*)((bf16_t*)out + off + bj * HALF) = w; }
                    else {
#pragma unroll
                        for (int n = 0; n < 2; ++n) __builtin_nontemporal_store(acc[ai][bj][m][n], (f32x4*)((float*)out + off + bj * HALF + n * 4)); }
                }
                if (WS) { float q = sq[mm]; q += __shfl_xor(q, 16); q += __shfl_xor(q, 32); if (fq == 0) atomicAdd(ss + rowb + m * 16, q); } }
            asm volatile("" ::: "memory");
        }
        if (WA) {
            f32x4 gm[2][2];
#pragma unroll
            for (int bj = 0; bj < 2; ++bj)
#pragma unroll
                for (int n = 0; n < 2; ++n) gm[bj][n] = *(const f32x4*)(gmul + (size_t)b * 1024 + col0 + bj * HALF + n * 4);
#pragma unroll
            for (int ai = 0; ai < 2; ++ai)
#pragma unroll
                for (int m = 0; m < 4; ++m) { const size_t off = (size_t)(u.pm * BM + ai * HALF + wr * 64 + fr + m * 16) * 1024 + col0;
#pragma unroll
                    for (int bj = 0; bj < 2; ++bj) { const f32x4 a0 = acc[ai][bj][m][0] * gm[bj][0], a1 = acc[ai][bj][m][1] * gm[bj][1]; u32x4 w; w.x = cvt_pk_bf16(a0[0], a0[1]); w.y = cvt_pk_bf16(a0[2], a0[3]); w.z = cvt_pk_bf16(a1[0], a1[1]); w.w = cvt_pk_bf16(a1[2], a1[3]);
                        *(u32x4*)(An + off + bj * HALF) = w; } }
        }
    }
};

struct EpiUp {
    static constexpr bool PERM = true, AFTER_DRAIN = false;
    bf16_t* act; const float* cw  ; const float* cb  ; float* halo; float* part; PG8_LAS unsigned char* xl  ;
    const float* ss  ; const float* cvec  ;
    __device__ __forceinline__ void prefetch(const Unit& u, int ui, int wid, int lane) const {
        PG8_LAS float* wl = (PG8_LAS float*)(xl + 8192 + 256) + (ui & 1) * 1536;
        const int t = wid * 64 + lane, c = t & 255, hi_ = t >> 8;
        const int gcol = (c >> 7) * 2816 + u.pn * HALF + (c & 127);
        const float* s0 = cw + (size_t)hi_ * 5632 + gcol;
        const float* s1 = hi_ == 0 ? cw + 2 * 5632 + gcol : cb + gcol;
        const float* s2 = hi_ == 0 ? ss + u.pm * BM + c : cvec + (size_t)(u.pm >> 5) * 5632 + u.pn * BM + c;
        __builtin_amdgcn_global_load_lds((const unsigned*)s0, (PG8_LAS unsigned*)(wl + wid * 64), 4, 0, 0);
        __builtin_amdgcn_global_load_lds((const unsigned*)s1, (PG8_LAS unsigned*)(wl + 512 + wid * 64), 4, 0, 0);
        __builtin_amdgcn_global_load_lds((const unsigned*)s2, (PG8_LAS unsigned*)(wl + 1024 + wid * 64), 4, 0, 0);
    }
    __device__ __forceinline__ void operator()(f32x4 (&acc)[2][2][4][2], const Unit& u, int wr, int wc, int fr, int fq, int wid, int lane, int ui) const {
        const int cbase = wc * 32 + 8 * fq;
        PG8_LAS float* wl = (PG8_LAS float*)(xl + 8192 + 256) + (ui & 1) * 1536;
        asm volatile("" ::: "memory");
        {
            f32x4 cv[2][2];
#pragma unroll
            for (int bj = 0; bj < 2; ++bj)
#pragma unroll
                for (int n = 0; n < 2; ++n) cv[bj][n] = *(const PG8_LAS f32x4*)(wl + 5 * 256 + bj * HALF + cbase + 4 * n);
#pragma unroll
            for (int ai = 0; ai < 2; ++ai)
#pragma unroll
                for (int m = 0; m < 4; ++m) { const float rs = __builtin_amdgcn_rsqf(wl[4 * 256 + ai * HALF + wr * 64 + m * 16 + fr] * (1.0f / 1024.0f) + 1e-6f);
#pragma unroll
                    for (int bj = 0; bj < 2; ++bj)
#pragma unroll
                        for (int n = 0; n < 2; ++n) acc[ai][bj][m][n] = acc[ai][bj][m][n] * rs + cv[bj][n]; }
        }
        if (fr >= 14) {
#pragma unroll
            for (int ai = 0; ai < 2; ++ai)
#pragma unroll
                for (int bj = 0; bj < 2; ++bj)
#pragma unroll
                    for (int n = 0; n < 2; ++n) *(PG8_LAS f32x4*)(xl + ((((ai * 2 + wr) * 2 + (fr - 14)) * 256) + bj * HALF + cbase + 4 * n) * 4) = acc[ai][bj][3][n];
            if (wr == 1) {
#pragma unroll
                for (int bj = 0; bj < 2; ++bj)
#pragma unroll
                    for (int n = 0; n < 2; ++n) *(f32x4*)(halo + ((size_t)(u.pm * 2 + (fr - 14)) * 5632 + bj * 2816 + u.pn * HALF + cbase + 4 * n)) = acc[1][bj][3][n];
            }
        }
        asm volatile("s_waitcnt lgkmcnt(0)" ::: "memory"); __builtin_amdgcn_s_barrier(); asm volatile("" ::: "memory");
#pragma unroll
        for (int n = 0; n < 2; ++n) {
            const int j0 = u.pn * HALF + cbase + 4 * n;
#pragma unroll
            for (int ai = 0; ai < 2; ++ai) {
                const int blk = ai * 2 + wr;
                const bool first = (blk == 0 && fr < 2);
#pragma unroll
                for (int bj = 1; bj >= 0; --bj) {
                    const PG8_LAS float* wp = wl + bj * HALF + cbase + 4 * n;
                    const f32x4 w0 = *(const PG8_LAS f32x4*)(wp), w1 = *(const PG8_LAS f32x4*)(wp + 256), w2 = *(const PG8_LAS f32x4*)(wp + 512), bb = *(const PG8_LAS f32x4*)(wp + 768);
                    f32x4 V = (f32x4){0.f, 0.f, 0.f, 0.f};
                    if (blk > 0 && fr >= 14) V = *(const PG8_LAS f32x4*)(xl + ((((blk - 1) * 2 + (fr - 14)) * 256) + bj * HALF + cbase + 4 * n) * 4);
                    asm volatile("s_nop 4" ::: "memory");
#pragma unroll
                    for (int m = 3; m >= 0; --m) {
                        const f32x4 cur = acc[ai][bj][m][n];
                        const f32x4 prv = m > 0 ? acc[ai][bj][m > 0 ? m - 1 : 0][n] : V;
                        f32x4 res; const f32x4 r4 = bb + w2 * cur;
#pragma unroll
                        for (int e = 0; e < 4; ++e) {
                            float r = r4[e];
                            const float c_ = cur[e], p_ = prv[e], w1_ = w1[e], w0_ = w0[e];
                            asm volatile("v_fmac_f32_dpp %0, %1, %2 row_shr:1 row_mask:0xf bank_mask:0xf" : "+v"(r) : "v"(c_), "v"(w1_));
                            asm volatile("v_fmac_f32_dpp %0, %1, %2 row_shr:2 row_mask:0xf bank_mask:0xf" : "+v"(r) : "v"(c_), "v"(w0_));
                            asm volatile("v_fmac_f32_dpp %0, %1, %2 row_shl:15 row_mask:0xf bank_mask:0xf" : "+v"(r) : "v"(p_), "v"(w1_));
                            asm volatile("v_fmac_f32_dpp %0, %1, %2 row_shl:14 row_mask:0xf bank_mask:0xf" : "+v"(r) : "v"(p_), "v"(w0_));
                            res[e] = r;
                        }
                        if (m == 0 && first) *(f32x4*)(part + (size_t)(u.pm * 2 + fr) * 5632 + bj * 2816 + j0) = res;
                        if (bj == 0) {
                            const f32x4 vv = acc[ai][1][m][n];
                            const f32x4 ng = res * (-1.4426950408889634f); f32x4 ex;
#pragma unroll
                            for (int e = 0; e < 4; ++e) ex[e] = __builtin_amdgcn_exp2f(ng[e]);
                            const f32x4 dn = ex + 1.0f; f32x4 rc;
#pragma unroll
                            for (int e = 0; e < 4; ++e) rc[e] = __builtin_amdgcn_rcpf(dn[e]);
                            res = (res * vv) * rc;
                        }
                        acc[ai][bj][m][n] = res;
                        asm volatile("" : "+v"(acc[ai][bj][m][n]));
                    }
                }
            }
        }
        const int row0 = u.pm * BM + wr * 64 + fr;
#pragma unroll
        for (int ai = 0; ai < 2; ++ai)
#pragma unroll
            for (int m = 0; m < 4; ++m) { const f32x4 v0 = acc[ai][0][m][0], v1 = acc[ai][0][m][1];
                u32x4 w; w.x = cvt_pk_bf16(v0[0], v0[1]); w.y = cvt_pk_bf16(v0[2], v0[3]); w.z = cvt_pk_bf16(v1[0], v1[1]); w.w = cvt_pk_bf16(v1[2], v1[3]);
                *(u32x4*)(act + (size_t)(row0 + ai * HALF + m * 16) * 2816 + u.pn * HALF + cbase) = w; }
    }
};

template <class Epi, class Sched, bool ALIGN_EPI = false, bool SP2 = false>
__device__ __forceinline__ void gemm_phase(PG8_LAS unsigned char* lds, const Gemm g, const Sched& S, const Epi& E) {
    const int tid = threadIdx.x, wid = __builtin_amdgcn_readfirstlane(tid >> 6), lane = tid & 63, wr = wid >> 2, wc = wid & 3, fr = lane & 15, fq = lane >> 4;
    const int K = g.K, nt = K / BK;
    unsigned voffA[2], voffB[2];
#pragma unroll
    for (int i = 0; i < 2; ++i) { int R, C; stage_rc(tid * 16 + i * 8192, R, C); const int Rb = Epi::PERM ? ((R & ~31) + perm32(R & 31)) : R;
        voffA[i] = (unsigned)(R * g.lda + C) * 2u; voffB[i] = (unsigned)(Rb * g.ldb + C) * 2u; }
    const size_t kstep = (size_t)(BK * 2);
    const size_t hsA = (size_t)HALF * g.lda * 2, hsB = (size_t)HALF * g.ldb * 2;
    const size_t tsA = 2 * hsA, tsB = 2 * hsB, pnA = (size_t)g.a_pn_off * 2;
    const unsigned ldsw = (unsigned)wid * 1024u;
    const int aoff = lds_byte(wr * 64 + fr, fq * 8), boff = lds_byte(wc * 32 + fr, fq * 8);
#define PG8_SA(b, h) (((b) * 2 + (h)) * HTB)
#define PG8_SB(b, h) ((4 + (b) * 2 + (h)) * HTB)
#define PG8_STAGE(bufoff, gbase, voff) do { _Pragma("unroll") for (int _i = 0; _i < 2; ++_i) \
        __builtin_amdgcn_global_load_lds((const unsigned*)((const char*)(gbase) + (voff)[_i]), (PG8_LAS unsigned*)(lds + (bufoff) + ldsw + _i * 8192), 16, 0, 0); } while (0)
#define PG8_LDA(dst, b, h) do { _Pragma("unroll") for (int m = 0; m < 4; ++m) _Pragma("unroll") for (int k = 0; k < 2; ++k) dst[m][k] = *(const PG8_LAS bf16x8*)(lds + PG8_SA(b, h) + aoff + m * 2048 + k * 1024); } while (0)
#define PG8_LDB(dst, b, h) do { _Pragma("unroll") for (int n = 0; n < 2; ++n) _Pragma("unroll") for (int k = 0; k < 2; ++k) dst[n][k] = *(const PG8_LAS bf16x8*)(lds + PG8_SB(b, h) + boff + n * 2048 + k * 1024); } while (0)
#define PG8_MMA(ai, bj, At, Bt) do { __builtin_amdgcn_s_setprio(1); _Pragma("unroll") for (int m = 0; m < 4; ++m) _Pragma("unroll") for (int n = 0; n < 2; ++n) _Pragma("unroll") for (int k = 0; k < 2; ++k) \
        acc[ai][bj][m][n] = __builtin_amdgcn_mfma_f32_16x16x32_bf16(Bt[n][k], At[m][k], acc[ai][bj][m][n], 0, 0, 0); __builtin_amdgcn_s_setprio(0); } while (0)
#define PG8_WAIT_V(n) asm volatile("s_waitcnt vmcnt(" #n ")" ::: "memory")
#define PG8_WAIT_L(n) asm volatile("s_waitcnt lgkmcnt(" #n ")" ::: "memory")
#define PG8_BAR __builtin_amdgcn_s_barrier()
#define PG8_SCHED __builtin_amdgcn_sched_barrier(0)
    Unit cur, nxt; int ui = 0;
    if (!S.next(0, cur)) return;
    f32x4 acc[2][2][4][2];
#pragma unroll
    for (int a = 0; a < 2; ++a)
#pragma unroll
        for (int b = 0; b < 2; ++b)
#pragma unroll
            for (int m = 0; m < 4; ++m)
#pragma unroll
                for (int n = 0; n < 2; ++n) acc[a][b][m][n] = (f32x4){0.f, 0.f, 0.f, 0.f};
    bf16x8 At[4][2], B0[2][2], B1[2][2];
    const char* cA = (const char*)g.A + (size_t)cur.pm * tsA + (size_t)cur.pn * pnA; const char* cB = (const char*)g.Bt + (size_t)cur.pn * tsB;
    S.a_ready(cur);
    E.prefetch(cur, 0, wid, lane);
    if constexpr (SP2) {
        PG8_STAGE(PG8_SB(0, 0), cB, voffB); PG8_STAGE(PG8_SB(0, 1), cB + hsB, voffB); PG8_STAGE(PG8_SA(0, 0), cA, voffA); PG8_STAGE(PG8_SA(0, 1), cA + hsA, voffA);
        if (wr == 1) PG8_BAR;
        PG8_WAIT_V(2); PG8_BAR;
        PG8_STAGE(PG8_SB(1, 0), cB + kstep, voffB); PG8_STAGE(PG8_SA(1, 0), cA + kstep, voffA); PG8_STAGE(PG8_SB(1, 1), cB + hsB + kstep, voffB);
        PG8_WAIT_V(6); PG8_BAR;
    } else {
        PG8_STAGE(PG8_SB(0, 0), cB, voffB); PG8_STAGE(PG8_SA(0, 0), cA, voffA); PG8_STAGE(PG8_SB(0, 1), cB + hsB, voffB); PG8_STAGE(PG8_SA(0, 1), cA + hsA, voffA);
        if (wr == 1) PG8_BAR;
        PG8_WAIT_V(4); PG8_BAR;
        PG8_STAGE(PG8_SB(1, 0), cB + kstep, voffB); PG8_STAGE(PG8_SA(1, 0), cA + kstep, voffA); PG8_STAGE(PG8_SB(1, 1), cB + hsB + kstep, voffB);
        PG8_WAIT_V(6); PG8_BAR;
    }
    for (;;) {
        const bool has_next = S.next(ui + 1, nxt);
        const char* nA = has_next ? (const char*)g.A + (size_t)nxt.pm * tsA + (size_t)nxt.pn * pnA : cA; const char* nB = has_next ? (const char*)g.Bt + (size_t)nxt.pn * tsB : cB;
        for (int t = 0; t < nt; t += 2) {
            const bool last = (t == nt - 2);
            const char* a1 = cA + (size_t)(t + 1) * kstep;
            const char* a2 = last ? nA : cA + (size_t)(t + 2) * kstep; const char* b2 = last ? nB : cB + (size_t)(t + 2) * kstep;
            const char* a3 = a2 + kstep; const char* b3 = b2 + kstep;
            if (last && has_next) S.a_ready(nxt);
            if constexpr (SP2) {
            PG8_LDB(B0, 0, 0); PG8_LDB(B1, 0, 1); PG8_SCHED; PG8_LDA(At, 0, 0); PG8_STAGE(PG8_SA(1, 1), a1 + hsA, voffA);
            PG8_WAIT_V(8); PG8_WAIT_L(0); PG8_BAR; PG8_MMA(0, 0, At, B0); PG8_MMA(0, 1, At, B1); PG8_BAR; PG8_SCHED;
            PG8_LDA(At, 0, 1); PG8_STAGE(PG8_SB(0, 0), b2, voffB); PG8_STAGE(PG8_SB(0, 1), b2 + hsB, voffB); PG8_STAGE(PG8_SA(0, 0), a2, voffA);
            PG8_WAIT_V(8); PG8_WAIT_L(0); PG8_BAR; PG8_MMA(1, 0, At, B0); PG8_MMA(1, 1, At, B1); PG8_BAR; PG8_SCHED;
            PG8_LDB(B0, 1, 0); PG8_LDB(B1, 1, 1); PG8_SCHED; PG8_LDA(At, 1, 0); PG8_STAGE(PG8_SA(0, 1), a2 + hsA, voffA);
            PG8_WAIT_V(8); PG8_WAIT_L(0); PG8_BAR; PG8_MMA(0, 0, At, B0); PG8_MMA(0, 1, At, B1); PG8_BAR; PG8_SCHED;
            PG8_LDA(At, 1, 1); PG8_STAGE(PG8_SB(1, 0), b3, voffB); PG8_STAGE(PG8_SB(1, 1), b3 + hsB, voffB); PG8_STAGE(PG8_SA(1, 0), a3, voffA);
            PG8_WAIT_V(8); PG8_WAIT_L(0); PG8_BAR; PG8_MMA(1, 0, At, B0); PG8_MMA(1, 1, At, B1); PG8_BAR; PG8_SCHED;
            } else {
            PG8_LDB(B0, 0, 0); PG8_SCHED; PG8_LDA(At, 0, 0); PG8_STAGE(PG8_SA(1, 1), a1 + hsA, voffA);
            PG8_WAIT_L(8); PG8_BAR; PG8_WAIT_L(0); PG8_MMA(0, 0, At, B0); PG8_BAR; PG8_SCHED;
            PG8_LDB(B1, 0, 1); PG8_STAGE(PG8_SB(0, 0), b2, voffB);
            PG8_BAR; PG8_WAIT_L(0); PG8_MMA(0, 1, At, B1); PG8_BAR;
            PG8_LDA(At, 0, 1); PG8_STAGE(PG8_SA(0, 0), a2, voffA);
            PG8_BAR; PG8_WAIT_L(0); PG8_MMA(1, 0, At, B0); PG8_BAR; PG8_SCHED;
            PG8_STAGE(PG8_SB(0, 1), b2 + hsB, voffB);
            PG8_WAIT_V(6); PG8_BAR; PG8_MMA(1, 1, At, B1); PG8_BAR;
            PG8_LDB(B0, 1, 0); PG8_SCHED; PG8_LDA(At, 1, 0); PG8_STAGE(PG8_SA(0, 1), a2 + hsA, voffA);
            PG8_WAIT_L(8); PG8_BAR; PG8_WAIT_L(0); PG8_MMA(0, 0, At, B0); PG8_BAR; PG8_SCHED;
            PG8_LDB(B1, 1, 1); PG8_STAGE(PG8_SB(1, 0), b3, voffB);
            PG8_BAR; PG8_WAIT_L(0); PG8_MMA(0, 1, At, B1); PG8_BAR;
            PG8_LDA(At, 1, 1); PG8_STAGE(PG8_SA(1, 0), a3, voffA);
            PG8_BAR; PG8_WAIT_L(0); PG8_MMA(1, 0, At, B0); PG8_BAR; PG8_SCHED;
            PG8_STAGE(PG8_SB(1, 1), b3 + hsB, voffB);
            PG8_WAIT_V(6); PG8_BAR; PG8_MMA(1, 1, At, B1); PG8_BAR;
            }
        }
        if constexpr (ALIGN_EPI) { if (wr == 0) PG8_BAR; }
        if constexpr (!Epi::AFTER_DRAIN) { E(acc, cur, wr, wc, fr, fq, wid, lane, ui); S.done(cur); }
        if (!has_next) break;
#pragma unroll
        for (int a = 0; a < 2; ++a)
#pragma unroll
            for (int b = 0; b < 2; ++b)
#pragma unroll
                for (int m = 0; m < 4; ++m)
#pragma unroll
                    for (int n = 0; n < 2; ++n) acc[a][b][m][n] = (f32x4){0.f, 0.f, 0.f, 0.f};
        cur = nxt; cA = nA; cB = nB; ++ui;
        E.prefetch(cur, ui, wid, lane);
        if constexpr (ALIGN_EPI) { if (wr == 1) PG8_BAR; }
    }
    PG8_WAIT_V(0);
    if constexpr (!ALIGN_EPI) { if (wr == 0) PG8_BAR; }
    PG8_BAR;
    if constexpr (Epi::AFTER_DRAIN) { E.fused(acc, cur, wr, wc, fr, fq, lds, wid, lane); S.done(cur); }
#undef PG8_SA
#undef PG8_SB
#undef PG8_STAGE
#undef PG8_LDA
#undef PG8_LDB
#undef PG8_MMA
#undef PG8_WAIT_V
#undef PG8_WAIT_L
#undef PG8_BAR
#undef PG8_SCHED
}
}

#define LAS __attribute__((address_space(3)))
typedef unsigned short bf16;
typedef float f32x4 __attribute__((ext_vector_type(4)));
typedef float f32x16 __attribute__((ext_vector_type(16)));
typedef short bf16x8 __attribute__((ext_vector_type(8)));
typedef short s16x4 __attribute__((ext_vector_type(4)));
typedef unsigned u32x4 __attribute__((ext_vector_type(4)));
typedef unsigned u32x2 __attribute__((ext_vector_type(2)));

constexpr int NWAVES = 8, NT = 512;
constexpr int SEQ = 8192, DM = 1024, M = 2 * SEQ, NQKV = 1536, DFF = 2816, NUP = 5632;
constexpr size_t MiB = 1u << 20;
constexpr size_t WS_CTL = 0, CTL_ZERO_BYTES = 65536;
constexpr size_t WS_MODP = 1 * MiB;
constexpr size_t WS_MODF = WS_MODP + 8 * 2 * 2 * 6144 * 4;
constexpr size_t WS_ROPE = 2 * MiB;
constexpr size_t WS_SS = 2 * MiB + 512 * 1024;
constexpr size_t WS_GM = 2 * MiB + 768 * 1024;
constexpr size_t WS_CVEC = 2 * MiB + 832 * 1024;
constexpr size_t WS_WQKV = 3 * MiB, WS_WO = 6 * MiB, WS_WPOOL = 8 * MiB, WS_WUP = 9 * MiB, WS_WDN = 31 * MiB;
constexpr size_t WS_HALO = 42 * MiB, WS_PART = 45 * MiB;
constexpr size_t WS_X = 48 * MiB;
constexpr size_t WS_H = 112 * MiB;
constexpr size_t WS_QKV = 144 * MiB;
constexpr size_t WS_ATT = 192 * MiB;
constexpr size_t WS_ACT = 144 * MiB;
constexpr size_t WS_END = 232 * MiB;
constexpr int CW_BAR = 1024;
constexpr int RING_BYTES = 131072, XL_OFF = 131072, MISC_OFF = XL_OFF + 8192, LDS_BYTES = 155648;
constexpr float LOG2E = 1.4426950408889634f, NORM_EPS = 1e-6f;

__device__ __forceinline__ unsigned pk2(float lo, float hi) { return pg8::cvt_pk_bf16(lo, hi); }
__device__ __forceinline__ float bf_lo(unsigned u) { return __uint_as_float(u << 16); }
__device__ __forceinline__ float bf_hi(unsigned u) { return __uint_as_float(u & 0xffff0000u); }
__device__ __forceinline__ float wave_sum(float v) {
#pragma unroll
    for (int o = 1; o < 64; o <<= 1) v += __shfl_xor(v, o);
    return v;
}

#define XB_TMO      128
#define XB_XCNT(j)  (256  + 64 * (j))
#define XB_XSUB(j)  (1280 + 64 * (j))
#define XB_XGEN(j)  (2304 + 64 * (j))
#define XB_TOP      3328
#define XB_TOPGEN   3392
#define XCD_BAR_WORDS 3456
#define XB_SPIN_CAP (1u << 20)
__device__ __forceinline__ unsigned xb_ld(unsigned* p)              { return __hip_atomic_load(p, __ATOMIC_RELAXED, __HIP_MEMORY_SCOPE_AGENT); }
__device__ __forceinline__ unsigned xb_add(unsigned* p, unsigned v) { return __hip_atomic_fetch_add(p, v, __ATOMIC_RELAXED, __HIP_MEMORY_SCOPE_AGENT); }
__device__ __forceinline__ unsigned xb_xcc_id() { return (unsigned)__builtin_amdgcn_s_getreg((3 << 11) | 20) & 0xFu; }
#define XB_SPIN(cond, bar) do { unsigned _sp = 0; while (cond) { __builtin_amdgcn_s_sleep(1); \
    if ((++_sp & 255u) == 0u) { if (xb_ld(&(bar)[XB_TMO])) break; if (_sp > XB_SPIN_CAP) { atomicAdd(&(bar)[XB_TMO], 1u); break; } } } } while (0)
struct XcdBarrier { unsigned* bar; unsigned x; volatile LAS unsigned* st; };
__device__ __forceinline__ XcdBarrier xcd_barrier_post(unsigned* bar, volatile LAS unsigned* st) {
    XcdBarrier b; b.bar = bar; b.x = xb_xcc_id(); b.st = st;
    if (threadIdx.x == 0) (void)xb_add(&bar[XB_XCNT(b.x)], 1u);
    return b;
}
__device__ __forceinline__ void xcd_barrier_complete(unsigned* bar, unsigned x, unsigned& nloc, unsigned& nx) {
    const unsigned G = gridDim.x * gridDim.y * gridDim.z;
    unsigned sum, cnt, mine, sp = 0u;
    for (;;) {
        sum = 0u; cnt = 0u; mine = 0u;
#pragma unroll
        for (unsigned j = 0; j < 16; ++j) { const unsigned c = xb_ld(&bar[XB_XCNT(j)]); sum += c; cnt += (c > 0u) ? 1u : 0u; mine = (j == x) ? c : mine; }
        if (sum == G) break;
        __builtin_amdgcn_s_sleep(1);
        if ((++sp & 255u) == 0u) { if (xb_ld(&bar[XB_TMO])) break; if (sp > XB_SPIN_CAP) { atomicAdd(&bar[XB_TMO], 1u); break; } }
    }
    nloc = mine > 0u ? mine : 1u; nx = cnt > 0u ? cnt : 1u;
}
__device__ __forceinline__ void xcd_barrier(const XcdBarrier& b) {
    asm volatile("s_waitcnt vmcnt(0)" ::: "memory");
    __syncthreads();
    if (threadIdx.x == 0) {
        unsigned* bar = b.bar;
        __builtin_amdgcn_s_waitcnt(0);
        unsigned nloc = b.st[0], nx = b.st[1];
        if (nloc == 0u) { xcd_barrier_complete(bar, b.x, nloc, nx); b.st[0] = nloc; b.st[1] = nx; }
        const unsigned old = xb_add(&bar[XB_XSUB(b.x)], 1u);
        const unsigned gen = old / nloc;
        if (old + 1u == (gen + 1u) * nloc) {
            __builtin_amdgcn_fence(__ATOMIC_RELEASE, "agent");
            asm volatile("s_waitcnt vmcnt(0)" ::: "memory");
            const unsigned og = xb_add(&bar[XB_TOP], 1u);
            const unsigned tg = og / nx;
            if (og + 1u == (tg + 1u) * nx) xb_add(&bar[XB_TOPGEN], 1u);
            else XB_SPIN(xb_ld(&bar[XB_TOPGEN]) == tg, bar);
            __builtin_amdgcn_fence(__ATOMIC_ACQUIRE, "agent");
            xb_add(&bar[XB_XGEN(b.x)], 1u);
            asm volatile("s_waitcnt vmcnt(0)" ::: "memory");
        } else {
            XB_SPIN(xb_ld(&bar[XB_XGEN(b.x)]) == gen, bar);
            __builtin_amdgcn_fence(__ATOMIC_ACQUIRE, "agent");
            asm volatile("s_waitcnt vmcnt(0)" ::: "memory");
        }
    }
    __syncthreads();
}

struct Ctx { LAS unsigned char* lds; int tid, lane, wave, G, vcu; unsigned char* ws; };

__device__ __forceinline__ void transpose_item(const float* W, int K, int N, bf16* WT, int k0, int n0, int dst_row0, LAS float* scr, int lane) {
    float tv[32];
#pragma unroll
    for (int i = 0; i < 32; ++i) tv[i] = __builtin_nontemporal_load(&W[(size_t)(k0 + 2 * i + (lane >> 5)) * N + n0 + (lane & 31)]);
#pragma unroll
    for (int i = 0; i < 32; ++i) scr[(2 * i + (lane >> 5)) * 33 + (lane & 31)] = tv[i];
    asm volatile("s_waitcnt lgkmcnt(0)" ::: "memory");
    const int c = lane & 7;
#pragma unroll
    for (int j = 0; j < 4; ++j) { const int n = (lane >> 3) + 8 * j; const LAS float* s = scr + (8 * c) * 33 + n;
        u32x4 o; o.x = pk2(s[0 * 33], s[1 * 33]); o.y = pk2(s[2 * 33], s[3 * 33]); o.z = pk2(s[4 * 33], s[5 * 33]); o.w = pk2(s[6 * 33], s[7 * 33]);
        *(u32x4*)(WT + (size_t)(dst_row0 + n) * K + k0 + 8 * c) = o; }
    asm volatile("s_waitcnt lgkmcnt(0)" ::: "memory");
}

__device__ __forceinline__ void ph_prologue(const Ctx& F, const float* const* in) {
    LAS float* cact = (LAS float*)(F.lds + XL_OFF);
    const float* c = in[1];
    for (int i = F.tid; i < 2048; i += NT) { const float v = c[i]; cact[i] = v / (1.0f + __expf(-v)); }
    __syncthreads();
    const int gw = F.vcu * NWAVES + F.wave, NGW = F.G * NWAVES;
    float* MODP = (float*)(F.ws + WS_MODP);
    typedef float f32x2_ __attribute__((ext_vector_type(2)));
    for (int it = gw; it < 768; it += NGW) {
        const int i = it / 384, r = it % 384, p = r / 48, cb = r % 48;
        const float* W = in[2] + (size_t)i * 1024 * 6144 + (size_t)(p * 128) * 6144 + cb * 128 + F.lane * 2;
        f32x2_ a0 = (f32x2_){0.f, 0.f}, a1 = a0;
#pragma unroll 64
        for (int k = 0; k < 128; ++k) { const f32x2_ w = __builtin_nontemporal_load((const f32x2_*)(W + (size_t)k * 6144)); const float c0 = cact[p * 128 + k], c1 = cact[1024 + p * 128 + k]; a0 += w * c0; a1 += w * c1; }
        *(f32x2_*)(MODP + ((size_t)((p * 2 + i) * 2 + 0)) * 6144 + cb * 128 + F.lane * 2) = a0;
        *(f32x2_*)(MODP + ((size_t)((p * 2 + i) * 2 + 1)) * 6144 + cb * 128 + F.lane * 2) = a1;
    }
    LAS float* scr = (LAS float*)(F.lds + F.wave * 16384);
    for (int it = (gw + NGW - (768 % NGW)) % NGW; it < 16 * 48; it += NGW) { const int kb = it / 48, nb = it % 48; transpose_item(in[6], 1024, 1536, (bf16*)(F.ws + WS_WQKV), 64 * kb, 32 * nb, 32 * nb, scr, F.lane); }
    { float* SS = (float*)(F.ws + WS_SS); for (int idx = F.vcu * NT + F.tid; idx < 3 * M; idx += F.G * NT) SS[idx] = 0.f; }
    float* rope = (float*)(F.ws + WS_ROPE);
    for (int idx = F.vcu * NT + F.tid; idx < 65536; idx += F.G * NT) {
        const int pos = idx >> 3, i = idx & 7;
        const float invf = i == 0 ? 1.0f : i == 1 ? 0.19392274474868576f : i == 2 ? 0.03760603093086393f : i == 3 ? 0.007292664737217109f : i == 4 ? 0.001414213562373095f : i == 5 ? 0.0002742481756762073f : i == 6 ? 5.318295896944988e-05f : 1.031338537721246e-05f;
        const float ang = (float)pos * invf;
        const float k = rintf(ang * 0.15915494309189535f);
        float r = fmaf(-k, 6.28125f, ang); r = fmaf(-k, 1.9353071795864769e-3f, r);
        rope[pos * 16 + i] = __cosf(r); rope[pos * 16 + 8 + i] = __sinf(r);
    }
}

__device__ __forceinline__ void convert_rest(const Ctx& F, const float* const* in, int w, int nw, int part) {
    LAS float* scr = (LAS float*)(F.lds + F.wave * 16384);
    const int gw = w * NWAVES + F.wave, NGW = nw * NWAVES;
    constexpr int I_WO = 16 * 32, I_POOL = 4 * 4 * 8, I_UP = 16 * 176, I_DN = 44 * 32;
    constexpr int NITEMS = I_WO + I_POOL + 2 * I_UP + 2 * I_DN;
    for (int it = gw; it < NITEMS; it += NGW) {
        int r = it;
        { int q = r; const bool l1 = (q >= I_WO + I_POOL + I_UP && q < I_WO + I_POOL + 2 * I_UP) || (q >= I_WO + I_POOL + 2 * I_UP);   if ((part == 1) != l1) continue; }
        if (r < I_WO) { const int kb = r / 32, nb = r % 32; transpose_item(in[10], 1024, 1024, (bf16*)(F.ws + WS_WO), 64 * kb, 32 * nb, 32 * nb, scr, F.lane); continue; } r -= I_WO;
        if (r < I_POOL) { const int g = r / 32, q = r % 32, kb = q / 8, nb = q % 8; transpose_item(in[11] + (size_t)g * 65536, 256, 256, (bf16*)(F.ws + WS_WPOOL) + (size_t)g * 65536, 64 * kb, 32 * nb, 32 * nb, scr, F.lane); continue; } r -= I_POOL;
        if (r < 2 * I_UP) { const int l = r / I_UP, q = r % I_UP, kb = q / 176, nb = q % 176, n0 = 32 * nb;
            const int dst = n0 < DFF ? (n0 / 128) * 256 + (n0 % 128) : ((n0 - DFF) / 128) * 256 + 128 + ((n0 - DFF) % 128);
            transpose_item(in[13] + (size_t)l * 1024 * NUP, 1024, NUP, (bf16*)(F.ws + WS_WUP) + (size_t)l * NUP * 1024, 64 * kb, n0, dst, scr, F.lane); continue; } r -= 2 * I_UP;
        { const int l = r / I_DN, q = r % I_DN, kb = q / 32, nb = q % 32;
            transpose_item(in[16] + (size_t)l * DFF * 1024, DFF, 1024, (bf16*)(F.ws + WS_WDN) + (size_t)l * 1024 * DFF, 64 * kb, 32 * nb, 32 * nb, scr, F.lane); }
    }
}

template <bool FROM_PART>
__device__ __forceinline__ void ph_norm(const Ctx& F, const float* X, const float* gain, const float* mod_b_layer, int layer, int chunk, bf16* H, const float* gain_ffn) {
    LAS float* gm = (LAS float*)F.lds; LAS float* sh = gm + 1024;
    const float* MODP = (const float*)(F.ws + WS_MODP); float* MODF = (float*)(F.ws + WS_MODF);
    if (FROM_PART) {
        for (int idx = F.vcu * NT + F.tid; idx < 2 * 2 * 6144; idx += F.G * NT) { const int i = idx / 12288, rem = idx % 12288, b = rem / 6144, col = rem % 6144;
            float t = ((const float*)mod_b_layer)[(size_t)(i - layer) * 6144 + col];
#pragma unroll
            for (int p = 0; p < 8; ++p) t += MODP[((size_t)((p * 2 + i) * 2 + b)) * 6144 + col];
            MODF[idx] = t; }
        float* GM = (float*)(F.ws + WS_GM);
        for (int idx = F.vcu * NT + F.tid; idx < 2 * 2 * 1024; idx += F.G * NT) { const int i = idx >> 11, b = (idx >> 10) & 1, c = idx & 1023;
            float t = ((const float*)mod_b_layer)[(size_t)(i - layer) * 6144 + 4 * 1024 + c];
#pragma unroll
            for (int p = 0; p < 8; ++p) t += MODP[((size_t)((p * 2 + i) * 2 + b)) * 6144 + 4 * 1024 + c];
            GM[idx] = gain_ffn[i * 1024 + c] * (1.0f + t); }
    }
    for (int rb = F.vcu; rb < 256; rb += F.G) {
        const int b = rb >> 7;
        __syncthreads();
        for (int c = F.tid; c < 1024; c += NT) {
            float t, s;
            if (FROM_PART) { t = mod_b_layer[chunk * 1024 + c]; s = mod_b_layer[(chunk + 1) * 1024 + c];
#pragma unroll
                for (int p = 0; p < 8; ++p) { const float* mp = MODP + ((size_t)((p * 2 + layer) * 2 + b)) * 6144; t += mp[chunk * 1024 + c]; s += mp[(chunk + 1) * 1024 + c]; } }
            else { const float* mf = MODF + (size_t)(layer * 2 + b) * 6144; t = mf[chunk * 1024 + c]; s = mf[(chunk + 1) * 1024 + c]; }
            gm[c] = gain[c] * (1.0f + s); sh[c] = t;
        }
        __syncthreads();
#pragma unroll 4
        for (int j = 0; j < 8; ++j) {
            const int row = rb * 64 + F.wave * 8 + j;
            const f32x4* xr = (const f32x4*)(X + (size_t)row * 1024) + F.lane;
            f32x4 v[4]; float ss = 0.f;
#pragma unroll
            for (int q = 0; q < 4; ++q) { v[q] = FROM_PART ? __builtin_nontemporal_load(xr + 64 * q) : xr[64 * q]; ss += (v[q].x * v[q].x + v[q].y * v[q].y) + (v[q].z * v[q].z + v[q].w * v[q].w); }
            const float rstd = rsqrtf(wave_sum(ss) * (1.0f / 1024.0f) + NORM_EPS);
            u32x2* o8 = (u32x2*)(H + (size_t)row * 1024) + F.lane;
#pragma unroll
            for (int q = 0; q < 4; ++q) { const f32x4 g4 = *(const LAS f32x4*)(gm + 256 * q + 4 * F.lane), s4 = *(const LAS f32x4*)(sh + 256 * q + 4 * F.lane);
                const f32x4 h = v[q] * rstd * g4 + s4; u32x2 w; w.x = pk2(h.x, h.y); w.y = pk2(h.z, h.w); o8[64 * q] = w; }
        }
    }
}

template <int W>
__device__ __forceinline__ void pool_rows(const bf16* Xg, bf16* Dg, int t0, int half, const LAS float* rs, f32x4 g4, f32x4 s4) {
    f32x4 ring[W]; f32x4 sum = (f32x4){0.f, 0.f, 0.f, 0.f};
#pragma unroll
    for (int k = 0; k < W; ++k) ring[k] = (f32x4){0.f, 0.f, 0.f, 0.f};
#pragma unroll 1
    for (int c = 0; c < 3; ++c) {
        u32x2 xr[16];
#pragma unroll
        for (int i = 0; i < 16; ++i) { const int jj = 16 * c + i, t = t0 - 15 + 32 * half + jj; xr[i] = (u32x2){0u, 0u}; if (jj < 47 && t >= 0) xr[i] = *(const u32x2*)(Xg + (size_t)t * 1024); }
#pragma unroll
        for (int i = 0; i < 16; ++i) {
            const int jj = 16 * c + i, j = 32 * half + jj, t = t0 - 15 + j;
            if (jj < 47) {
                const f32x4 xv = (f32x4){bf_lo(xr[i].x), bf_hi(xr[i].x), bf_lo(xr[i].y), bf_hi(xr[i].y)};
                f32x4 h = xv * rs[j] * g4 + s4;
                if (t < 0) h = (f32x4){0.f, 0.f, 0.f, 0.f};
                sum = sum + h - ring[W - 1];
#pragma unroll
                for (int k = W - 1; k > 0; --k) ring[k] = ring[k - 1];
                ring[0] = h;
                if (jj >= 15) {
                    const float inv = 1.0f / (float)((t + 1) < W ? (t + 1) : W);
                    const f32x4 d = sum * inv - h;
                    u32x2 w; w.x = pk2(d.x, d.y); w.y = pk2(d.z, d.w);
                    *(u32x2*)(Dg + (size_t)t * 1024) = w;
                }
            }
        }
    }
}
__device__ __forceinline__ void ph_pooldiff(const Ctx& F, const bf16* X, const float* gain, int layer, bf16* D, const float* SSQ) {
    LAS float* gm = (LAS float*)F.lds; LAS float* sh = gm + 1024; LAS float* rs = sh + 1024;
    const float* MODF = (const float*)(F.ws + WS_MODF);
    for (int rb = F.vcu; rb < 256; rb += F.G) {
        const int b = rb >> 7, t0 = (rb & 127) * 64;
        __syncthreads();
        for (int c = F.tid; c < 1024; c += NT) { const float* mf = MODF + (size_t)(layer * 2 + b) * 6144; gm[c] = gain[c] * (1.0f + mf[1024 + c]); sh[c] = mf[c]; }
        for (int j = F.tid; j < 79; j += NT) { const int t = t0 - 15 + j; rs[j] = t >= 0 ? rsqrtf(SSQ[(size_t)b * SEQ + t] * (1.0f / 1024.0f) + NORM_EPS) : 0.f; }
        __syncthreads();
        const int g = F.wave & 3, half = F.wave >> 2;
        const f32x4 g4 = *(const LAS f32x4*)(gm + 256 * g + 4 * F.lane), s4 = *(const LAS f32x4*)(sh + 256 * g + 4 * F.lane);
        const bf16* Xg = X + (size_t)b * SEQ * 1024 + 256 * g + 4 * F.lane; bf16* Dg = D + (size_t)b * SEQ * 1024 + 256 * g + 4 * F.lane;
        if (g == 0) pool_rows<2>(Xg, Dg, t0, half, rs, g4, s4); else if (g == 1) pool_rows<4>(Xg, Dg, t0, half, rs, g4, s4);
        else if (g == 2) pool_rows<8>(Xg, Dg, t0, half, rs, g4, s4); else pool_rows<16>(Xg, Dg, t0, half, rs, g4, s4);
    }
}

__device__ __forceinline__ int crow(int r, int hi) { return (r & 3) + 8 * (r >> 2) + 4 * hi; }
__device__ __forceinline__ void ph_attn(const Ctx& F, const bf16* QKV, const float* qgain, const float* kgain, const float* sinks, bf16* ATT) {
    constexpr int KS = 144, VS = 520;
    LAS unsigned char* Ks = F.lds; LAS unsigned char* Vt = F.lds + 256 * KS;
    LAS float* QR = (LAS float*)(F.lds + 256 * KS + 64 * VS);
    LAS float* GN = QR + 128 * 16;
    LAS float* KR = GN + 256;
    const float* rope = (const float*)(F.ws + WS_ROPE);
    if (F.tid < 128) GN[F.tid] = F.tid < 64 ? qgain[F.tid] : kgain[F.tid - 64];
    const int r32 = F.lane & 31, hi = F.lane >> 5;
    for (int u = F.vcu; u < 512; u += F.G) {
        const int b = u >> 8, n = (u >> 2) & 63, hk = u & 3;
        const int tok0 = b * SEQ + n * 128;
        __syncthreads();
        const int g = F.wave >> 1, qh = F.wave & 1, hq = hk * 4 + g;
        u32x4 kraw[4], vraw[4];
#pragma unroll
        for (int i = 0; i < 4; ++i) {
            const int item = F.tid + NT * i, key = item >> 3, c = item & 7;
            const int pos = n * 128 - 128 + key;
            kraw[i] = (u32x4){0u, 0u, 0u, 0u}; vraw[i] = kraw[i];
            if (pos >= 0) { const bf16* rowp = QKV + (size_t)(b * SEQ + pos) * NQKV; kraw[i] = *(const u32x4*)(rowp + 1024 + hk * 64 + 8 * c); }
            { const int vkey = item & 255, vc = item >> 8, vpos = n * 128 - 128 + vkey;
              if (vpos >= 0) vraw[i] = *(const u32x4*)(QKV + (size_t)(b * SEQ + vpos) * NQKV + 1280 + hk * 64 + 8 * vc); }
        }
        f32x4 krr[2];
#pragma unroll
        for (int i = 0; i < 2; ++i) { const int fi = F.tid * 4 + i * 2048, kp = n * 128 - 128 + (fi >> 4); krr[i] = *(const f32x4*)(rope + (size_t)(kp >= 0 ? kp : 0) * 16 + (fi & 15)); }
        const f32x4 qrr = *(const f32x4*)(rope + (size_t)(n * 128) * 16 + F.tid * 4);
        u32x4 qnext[4];
        { const bf16* qrow = QKV + (size_t)(tok0 + 64 * qh + r32) * NQKV + hq * 64;
#pragma unroll
          for (int d0 = 0; d0 < 4; ++d0) qnext[d0] = *(const u32x4*)(qrow + 16 * d0 + 8 * hi); }
#pragma unroll
        for (int i = 0; i < 2; ++i) *(LAS f32x4*)(KR + F.tid * 4 + i * 2048) = krr[i];
        *(LAS f32x4*)(QR + F.tid * 4) = qrr;
        __syncthreads();
#pragma unroll
        for (int i = 0; i < 4; ++i) {
            const int item = F.tid + NT * i, key = item >> 3, c = item & 7;
            float kf[8], pf[8];
#pragma unroll
            for (int e = 0; e < 4; ++e) { kf[2 * e] = bf_lo(kraw[i][e]); kf[2 * e + 1] = bf_hi(kraw[i][e]); }
            float ss = 0.f;
#pragma unroll
            for (int e = 0; e < 8; ++e) ss += kf[e] * kf[e];
            ss += __shfl_xor(ss, 1); ss += __shfl_xor(ss, 2); ss += __shfl_xor(ss, 4);
            const float rstd = rsqrtf(ss * (1.0f / 64.0f) + NORM_EPS);
#pragma unroll
            for (int e = 0; e < 8; ++e) kf[e] *= rstd * GN[64 + 8 * c + e];
#pragma unroll
            for (int e = 0; e < 8; ++e) pf[e] = __shfl_xor(kf[e], 1);
            if (c < 2) {
                const LAS float* rp = KR + key * 16;
#pragma unroll
                for (int e = 0; e < 8; ++e) { const float cs = rp[e], sn = rp[8 + e]; kf[e] = (c == 0) ? kf[e] * cs - pf[e] * sn : kf[e] * cs + pf[e] * sn; }
            }
            u32x4 ko; ko.x = pk2(kf[0], kf[1]); ko.y = pk2(kf[2], kf[3]); ko.z = pk2(kf[4], kf[5]); ko.w = pk2(kf[6], kf[7]);
            *(LAS u32x4*)(Ks + key * KS + c * 16) = ko;
            const int vkey = item & 255, vc = item >> 8;
#pragma unroll
            for (int e = 0; e < 4; ++e) {
                *(LAS unsigned short*)(Vt + (8 * vc + 2 * e) * VS + vkey * 2) = (unsigned short)(vraw[i][e] & 0xffffu);
                *(LAS unsigned short*)(Vt + (8 * vc + 2 * e + 1) * VS + vkey * 2) = (unsigned short)(vraw[i][e] >> 16);
            }
        }
        __syncthreads();
        const float sink2 = sinks[hq] * LOG2E;
#pragma unroll 1
        for (int qb = 0; qb < 2; ++qb) {
            const int q0 = 64 * qh + 32 * qb;
            float qf[4][8]; float ss = 0.f;
            u32x4 qcur[4];
#pragma unroll
            for (int d0 = 0; d0 < 4; ++d0) qcur[d0] = qnext[d0];
            if (qb == 0) { const bf16* qrow = QKV + (size_t)(tok0 + q0 + 32 + r32) * NQKV + hq * 64;
#pragma unroll
                for (int d0 = 0; d0 < 4; ++d0) qnext[d0] = *(const u32x4*)(qrow + 16 * d0 + 8 * hi); }
#pragma unroll
            for (int d0 = 0; d0 < 4; ++d0) { const u32x4 raw = qcur[d0];
#pragma unroll
                for (int e = 0; e < 4; ++e) { qf[d0][2 * e] = bf_lo(raw[e]); qf[d0][2 * e + 1] = bf_hi(raw[e]); } }
#pragma unroll
            for (int d0 = 0; d0 < 4; ++d0)
#pragma unroll
                for (int e = 0; e < 8; ++e) ss += qf[d0][e] * qf[d0][e];
            ss += __shfl_xor(ss, 32);
            const float rstd = rsqrtf(ss * (1.0f / 64.0f) + NORM_EPS);
#pragma unroll
            for (int d0 = 0; d0 < 4; ++d0)
#pragma unroll
                for (int e = 0; e < 8; ++e) qf[d0][e] *= rstd * GN[16 * d0 + 8 * hi + e];
            {
                const LAS float* rp = QR + (q0 + r32) * 16;
#pragma unroll
                for (int e = 0; e < 8; ++e) { const float pf = __shfl_xor(qf[0][e], 32); const float cs = rp[e], sn = rp[8 + e]; qf[0][e] = (hi == 0) ? qf[0][e] * cs - pf * sn : qf[0][e] * cs + pf * sn; }
            }
            bf16x8 qfr[4];
#pragma unroll
            for (int d0 = 0; d0 < 4; ++d0) { u32x4 w; const float sc = 0.125f * LOG2E;
                w.x = pk2(qf[d0][0] * sc, qf[d0][1] * sc); w.y = pk2(qf[d0][2] * sc, qf[d0][3] * sc); w.z = pk2(qf[d0][4] * sc, qf[d0][5] * sc); w.w = pk2(qf[d0][6] * sc, qf[d0][7] * sc);
                qfr[d0] = __builtin_bit_cast(bf16x8, w); }
            f32x16 S[5];
#pragma unroll
            for (int kb = 0; kb < 5; ++kb) {
                S[kb] = (f32x16){0.f, 0.f, 0.f, 0.f, 0.f, 0.f, 0.f, 0.f, 0.f, 0.f, 0.f, 0.f, 0.f, 0.f, 0.f, 0.f};
#pragma unroll
                for (int d0 = 0; d0 < 4; ++d0) { const bf16x8 a = *(const LAS bf16x8*)(Ks + (q0 + 32 * kb + r32) * KS + (16 * d0 + 8 * hi) * 2);
                    S[kb] = __builtin_amdgcn_mfma_f32_32x32x16_bf16(a, qfr[d0], S[kb], 0, 0, 0); }
            }
            const float NEG = -1e30f;
#pragma unroll
            for (int r = 0; r < 16; ++r) { if (crow(r, hi) <= r32) S[0][r] = NEG; if (crow(r, hi) > r32) S[4][r] = NEG; }
            if (n == 0) {
#pragma unroll
                for (int kb = 0; kb < 5; ++kb)
#pragma unroll
                    for (int r = 0; r < 16; ++r) if (q0 + 32 * kb + crow(r, hi) < 128) S[kb][r] = NEG;
            }
            float mx = sink2;
#pragma unroll
            for (int kb = 0; kb < 5; ++kb)
#pragma unroll
                for (int r = 0; r < 16; ++r) mx = fmaxf(mx, S[kb][r]);
            mx = fmaxf(mx, __shfl_xor(mx, 32));
            float sum = 0.f;
#pragma unroll
            for (int kb = 0; kb < 5; ++kb)
#pragma unroll
                for (int r = 0; r < 16; ++r) { const float p = __builtin_amdgcn_exp2f(S[kb][r] - mx); S[kb][r] = p; sum += p; }
            sum += __shfl_xor(sum, 32);
            sum += __builtin_amdgcn_exp2f(sink2 - mx);
            const float inv = 1.0f / sum;
            f32x16 O[2];
            O[0] = (f32x16){0.f, 0.f, 0.f, 0.f, 0.f, 0.f, 0.f, 0.f, 0.f, 0.f, 0.f, 0.f, 0.f, 0.f, 0.f, 0.f}; O[1] = O[0];
#pragma unroll
            for (int kb = 0; kb < 5; ++kb)
#pragma unroll
                for (int hf = 0; hf < 2; ++hf) {
                    u32x4 pw; pw.x = pk2(S[kb][8 * hf + 0], S[kb][8 * hf + 1]); pw.y = pk2(S[kb][8 * hf + 2], S[kb][8 * hf + 3]); pw.z = pk2(S[kb][8 * hf + 4], S[kb][8 * hf + 5]); pw.w = pk2(S[kb][8 * hf + 6], S[kb][8 * hf + 7]);
                    const bf16x8 pfrag = __builtin_bit_cast(bf16x8, pw);
                    const int base = q0 + 32 * kb + 16 * hf;
#pragma unroll
                    for (int db = 0; db < 2; ++db) {
                        const u32x2 lo = *(const LAS u32x2*)(Vt + (32 * db + r32) * VS + (base + 4 * hi) * 2), hi2 = *(const LAS u32x2*)(Vt + (32 * db + r32) * VS + (base + 8 + 4 * hi) * 2);
                        u32x4 vw; vw.x = lo.x; vw.y = lo.y; vw.z = hi2.x; vw.w = hi2.y;
                        O[db] = __builtin_amdgcn_mfma_f32_32x32x16_bf16(__builtin_bit_cast(bf16x8, vw), pfrag, O[db], 0, 0, 0);
                    }
                }
            bf16* orow = ATT + (size_t)(tok0 + q0 + r32) * 1024 + hq * 64;
#pragma unroll
            for (int db = 0; db < 2; ++db)
#pragma unroll
                for (int rg = 0; rg < 4; ++rg) { u32x2 w; w.x = pk2(O[db][4 * rg] * inv, O[db][4 * rg + 1] * inv); w.y = pk2(O[db][4 * rg + 2] * inv, O[db][4 * rg + 3] * inv);
                    *(u32x2*)(orow + 32 * db + 8 * rg + 4 * hi) = w; }
        }
    }
}

__device__ __forceinline__ void cvec_job(const Ctx& F, int l) {
    const float* MODF = (const float*)(F.ws + WS_MODF); float* CV = (float*)(F.ws + WS_CVEC);
    const int gw = F.vcu * NWAVES + F.wave, NGW = F.G * NWAVES;
    for (int r = gw; r < NUP; r += NGW) {
        const bf16* wrow = (const bf16*)(F.ws + WS_WUP) + ((size_t)l * NUP + r) * 1024;
        float d0 = 0.f, d1 = 0.f;
#pragma unroll
        for (int h = 0; h < 2; ++h) { const int k0 = h * 512 + F.lane * 8; const u32x4 w = *(const u32x4*)(wrow + k0);
            const float* s0 = MODF + (size_t)(l * 2 + 0) * 6144 + 3 * 1024 + k0; const float* s1 = MODF + (size_t)(l * 2 + 1) * 6144 + 3 * 1024 + k0;
#pragma unroll
            for (int e = 0; e < 4; ++e) { const float wl = bf_lo(w[e]), wh = bf_hi(w[e]); d0 += wl * s0[2 * e] + wh * s0[2 * e + 1]; d1 += wl * s1[2 * e] + wh * s1[2 * e + 1]; } }
        d0 = wave_sum(d0); d1 = wave_sum(d1);
        if (F.lane == 0) { CV[(size_t)(l * 2 + 0) * NUP + r] = d0; CV[(size_t)(l * 2 + 1) * NUP + r] = d1; }
    }
}

__device__ __forceinline__ void fixup_tile(const Ctx& F, const float* cw, bf16* ACT, int pm) {
    if ((pm & 31) == 0) return;
    const float* HALO = (const float*)(F.ws + WS_HALO); const float* PART = (const float*)(F.ws + WS_PART);
    static_assert(2 * DFF == 11 * NT, "fixup_tile: 11 outputs per thread");
#pragma unroll
    for (int it = 0; it < 11; ++it) {
        const int idx = F.tid + it * NT;
        const int fr = idx / DFF, j = idx % DFF;
        const float* hb = HALO + (size_t)((pm - 1) * 2) * NUP; const float* pb = PART + (size_t)(pm * 2 + fr) * NUP;
        float g = pb[j], v = pb[DFF + j];
        const float h0g = hb[j], h1g = hb[NUP + j], h0v = hb[DFF + j], h1v = hb[NUP + DFF + j];
        if (fr == 0) { g += cw[NUP + j] * h1g + cw[j] * h0g; v += cw[NUP + DFF + j] * h1v + cw[DFF + j] * h0v; }
        else { g += cw[j] * h1g; v += cw[DFF + j] * h1v; }
        const float a = pg8::silu_f(g) * v;
        ACT[(size_t)(pm * 256 + fr) * DFF + j] = (bf16)(pk2(a, a) & 0xffffu);
    }
}

struct Args { const float* in[17]; float* out; unsigned char* ws; int ph_lo, ph_hi, use_cg, pad; };
constexpr int NPHASE = 11;

__global__ void __launch_bounds__(NT, 2) fwd_kernel(Args args) {
    extern __shared__ __attribute__((aligned(16))) unsigned char lds_raw[];
    Ctx F;
    F.lds = (LAS unsigned char*)lds_raw; F.tid = threadIdx.x; F.lane = F.tid & 63; F.wave = __builtin_amdgcn_readfirstlane(F.tid >> 6);
    F.G = gridDim.x; { const int bx = blockIdx.x; F.vcu = (F.G % 8 == 0) ? (bx % 8) * (F.G / 8) + bx / 8 : bx; }
    F.ws = args.ws;
    unsigned icw = 0u;
    { const unsigned long long pc = ((unsigned long long)__builtin_amdgcn_s_getpc()) & ~15ull;
      if (F.tid < 360) { const u32x4 cv = *(const volatile u32x4*)(pc + (unsigned long long)(((int)blockIdx.x >> 3) & 31) * 5760ull + (unsigned long long)F.tid * 16ull); icw = cv.x ^ cv.y ^ cv.z ^ cv.w; } }
    volatile LAS unsigned* MISC = (volatile LAS unsigned*)(F.lds + MISC_OFF);
    if (F.tid < 16) MISC[F.tid] = 0u;
    __syncthreads();
    XcdBarrier bar = xcd_barrier_post((unsigned*)(F.ws + WS_CTL) + CW_BAR, MISC + 8);
    const int lo = args.ph_lo, hi = args.ph_hi;
#ifndef PHASE_MASK
#define PHASE_MASK 0x7ff
#endif
#define IN(k) (((PHASE_MASK >> (k)) & 1) && lo <= (k) && (k) < hi)
#ifndef DUP_BAR
#define DUP_BAR 0
#endif
#ifndef DUP_MASK
#define DUP_MASK 0
#endif
#define REP(k) for (int rep_ = 0; rep_ < 1 + ((DUP_MASK >> (k)) & 1); ++rep_)
#define SEAM(k) do { if (IN(k) && IN((k) + 1)) { if (args.use_cg) cg::this_grid().sync(); else { xcd_barrier(bar); if (DUP_BAR) xcd_barrier(bar); } } } while (0)
    const float* const* in = args.in;
      bf16* X = (bf16*)(F.ws + WS_X); bf16* H = (bf16*)(F.ws + WS_H); bf16* QKV = (bf16*)(F.ws + WS_QKV); bf16* ATT = (bf16*)(F.ws + WS_ATT); bf16* ACT = (bf16*)(F.ws + WS_ACT);
    const float* MODF = (const float*)(F.ws + WS_MODF);
    LAS unsigned char* xl = F.lds + XL_OFF;

    float* SS = (float*)(F.ws + WS_SS); const float* GM = (const float*)(F.ws + WS_GM); const float* CV = (const float*)(F.ws + WS_CVEC);
    if (IN(0)) REP(0) ph_prologue(F, in);
    if (icw == 0x9E3779B9u && args.use_cg) ((unsigned*)(F.ws + WS_CTL + 61440))[F.tid] = icw;
    SEAM(0);
    if (IN(1)) REP(1) ph_norm<true>(F, in[0], in[4], in[3], 0, 0, H, in[5]);
    SEAM(1);
    if (IN(2)) { pg8::Gemm g{H, (const bf16*)(F.ws + WS_WQKV), 1024, 1024, 1024, 0}; pg8::StaticOrder S; S.init(M, NQKV, F.G, (int)blockIdx.x);
        pg8::EpiBf16 E{QKV, NQKV}; pg8::gemm_phase<pg8::EpiBf16, pg8::StaticOrder, true, true>(F.lds, g, S, E);
        if ((DUP_MASK >> 2) & 1) { __syncthreads(); pg8::gemm_phase<pg8::EpiBf16, pg8::StaticOrder, true, true>(F.lds, g, S, E); }
        { const int nwg = (M / 256) * (NQKV / 256), rounds = (nwg + F.G - 1) / F.G, nidle = rounds * F.G - nwg, c = (int)blockIdx.x;
          __syncthreads();
          if (nidle == 0) convert_rest(F, in, c, F.G, 0); else if (c >= F.G - nidle) convert_rest(F, in, c - (F.G - nidle), nidle, 0); } }
    SEAM(2);
    if (IN(3)) { REP(3) ph_attn(F, QKV, in[7], in[8], in[9], ATT); cvec_job(F, 0); }
    SEAM(3);
    if (IN(4)) { pg8::Gemm g{ATT, (const bf16*)(F.ws + WS_WO), 1024, 1024, 1024, 0}; pg8::StaticOrder S; S.init(M, 1024, F.G, (int)blockIdx.x);
        pg8::EpiRes<true, true, false, true> E{in[0], X, MODF + 0 * 12288 + 2 * 1024, nullptr, H, GM, SS}; pg8::gemm_phase<pg8::EpiRes<true, true, false, true>, pg8::StaticOrder, true, true>(F.lds, g, S, E); }
    SEAM(4);
#define UP(l, ph) do { if (IN(ph)) { pg8::Gemm g{H, (const bf16*)(F.ws + WS_WUP) + (size_t)(l) * NUP * 1024, 1024, 1024, 1024, 0}; pg8::StaticOrder S; S.init(M, NUP, F.G, (int)blockIdx.x); \
            pg8::EpiUp E{ACT, in[14] + (size_t)(l) * 3 * NUP, in[15] + (size_t)(l) * NUP, (float*)(F.ws + WS_HALO), (float*)(F.ws + WS_PART), xl, SS + (size_t)(2 * (l)) * M, CV + (size_t)(l) * 2 * NUP}; \
            pg8::gemm_phase<pg8::EpiUp, pg8::StaticOrder, true, true>(F.lds, g, S, E); \
            if ((l) == 0) { const int nwg = (M / 256) * (NUP / 256), rounds = (nwg + F.G - 1) / F.G, nidle = rounds * F.G - nwg, c = (int)blockIdx.x; __syncthreads(); \
                if (nidle == 0) convert_rest(F, in, c, F.G, 1); else if (c >= F.G - nidle) convert_rest(F, in, c - (F.G - nidle), nidle, 1); } } } while (0)
#define DOWN_PRE(l) pg8::Gemm g{ACT, (const bf16*)(F.ws + WS_WDN) + (size_t)(l) * 1024 * DFF, DFF, DFF, DFF, 0}; pg8::StaticOrder S; S.init(M, 1024, F.G, (int)blockIdx.x); \
            { pg8::Unit fu; for (int fi = 0; S.next(fi, fu); ++fi) fixup_tile(F, in[14] + (size_t)(l) * 3 * NUP, ACT, fu.pm); asm volatile("s_waitcnt vmcnt(0)" ::: "memory"); __syncthreads(); }
    UP(0, 5);
    SEAM(5);
    if (IN(6)) { DOWN_PRE(0)
        pg8::EpiRes<false, true, true, true> E{X, X, MODF + 0 * 12288 + 5 * 1024, nullptr, nullptr, nullptr, SS + M}; pg8::gemm_phase<pg8::EpiRes<false, true, true, true>, pg8::StaticOrder, true, true>(F.lds, g, S, E); }
    SEAM(6);
    if (IN(7)) { REP(7) ph_pooldiff(F, X, in[4] + 1024, 1, ATT, SS + M); cvec_job(F, 1); }
    SEAM(7);
    if (IN(8)) { pg8::Gemm g{ATT, (const bf16*)(F.ws + WS_WPOOL), 1024, 256, 256, 256}; pg8::StaticOrder S; S.init(M, 1024, F.G, (int)blockIdx.x);
        pg8::EpiRes<true, true, true, true> E{X, X, MODF + 1 * 12288 + 2 * 1024, in[12], H, GM + 2048, SS + 2 * M}; pg8::gemm_phase<pg8::EpiRes<true, true, true, true>, pg8::StaticOrder, true, true>(F.lds, g, S, E); }
    SEAM(8);
    UP(1, 9);
    SEAM(9);
    if (IN(10)) { DOWN_PRE(1)
        pg8::EpiRes<false, false, true, false> E{X, args.out, MODF + 1 * 12288 + 5 * 1024, nullptr, nullptr, nullptr, nullptr}; pg8::gemm_phase<pg8::EpiRes<false, false, true, false>, pg8::StaticOrder, true, true>(F.lds, g, S, E); }
#undef UP
#undef DOWN_PRE
#undef IN
#undef SEAM
}

extern "C" void kernel_launch(void* const* d_in, const int* in_sizes, int n_in, void* d_out, int out_size, void* d_ws, size_t ws_size, hipStream_t stream) {
    static int grid = 0;
    if (grid == 0) {
        if (n_in != 17 || out_size != M * DM || ws_size < WS_END) { fprintf(stderr, "kernel_launch: unexpected shapes (n_in %d out %d ws %zu)\n", n_in, out_size, ws_size); grid = -1; return; }
        int dev = 0, cus = 0, per_cu = 0;
        if (hipGetDevice(&dev) != hipSuccess || hipDeviceGetAttribute(&cus, hipDeviceAttributeMultiprocessorCount, dev) != hipSuccess) { grid = -1; return; }
        if (hipFuncSetAttribute((const void*)fwd_kernel, hipFuncAttributeMaxDynamicSharedMemorySize, LDS_BYTES) != hipSuccess) { fprintf(stderr, "kernel_launch: hipFuncSetAttribute failed\n"); grid = -1; return; }
        if (hipOccupancyMaxActiveBlocksPerMultiprocessor(&per_cu, (const void*)fwd_kernel, NT, LDS_BYTES) != hipSuccess || per_cu < 1) { fprintf(stderr, "kernel_launch: occupancy query says %d\n", per_cu); per_cu = 1; }
        (void)hipGetLastError();
        grid = cus * 1;
    }
    if (grid < 0) return;
    (void)hipMemsetAsync((char*)d_ws + WS_CTL, 0, CTL_ZERO_BYTES, stream);
    Args a{};
    for (int i = 0; i < 17; ++i) a.in[i] = (const float*)d_in[i];
    a.out = (float*)d_out; a.ws = (unsigned char*)d_ws; a.ph_lo = 0; a.ph_hi = NPHASE; a.use_cg = 0; a.pad = 0;
    void* kargs[] = {&a};
    hipError_t e = hipLaunchCooperativeKernel((const void*)fwd_kernel, dim3(grid), dim3(NT), kargs, LDS_BYTES, stream);
    if (e != hipSuccess) fprintf(stderr, "kernel_launch: cooperative launch failed: %s (grid %d)\n", hipGetErrorString(e), grid);
}
```
